# Optimizing an MI355X kernel written in HIP

```python
import math
import jax, jax.numpy as jnp
from jax import lax
import numpy as np

D_MODEL = 1024
BATCH = 8
SEQ = 4096
DEPTH = 1

A_HEADS = 8
A_GROUPS = 2
A_HPG = A_HEADS // A_GROUPS
HEAD_DIM = 64
A_WIDTH = A_HEADS * HEAD_DIM
KV_WIDTH = A_GROUPS * HEAD_DIM
CMP_BLOCK = 32
CMP_STRIDE = 16
CMP_HIDDEN = 128
SLC_BLOCK = 64
SLC_TOP_N = 16
WINDOW = 512
Q_BLOCK = 128
ROPE_THETA = 10000.0
FORCE_SCORE = 1e30
B_HEADS = 4
B_KDIM = 128
B_VDIM = 128
B_FWIDTH = B_HEADS * B_KDIM
B_WIDTH = B_HEADS * B_VDIM
CHUNK = 64
NORM_EPS = 1e-5

IN_SPLITS = (A_WIDTH,
             6 * KV_WIDTH,
             A_HEADS * 3,
             A_WIDTH,
             B_FWIDTH,
             B_FWIDTH,
             B_WIDTH,
             B_WIDTH,
             D_MODEL,
             D_MODEL)
IN_WIDTH = sum(IN_SPLITS)
SPLIT_POINTS = tuple(int(v) for v in np.cumsum(IN_SPLITS)[:-1])

kernel_name = "nsa_hgrn2_gated_parallel_deepnorm"


def layer_norm(x, g, b):
    xf = x.astype(jnp.float32)
    mu = jnp.mean(xf, axis=-1, keepdims=True)
    var = jnp.mean(jnp.square(xf - mu), axis=-1, keepdims=True)
    y = (xf - mu) * lax.rsqrt(var + NORM_EPS) * g.astype(jnp.float32) + b.astype(jnp.float32)
    return y.astype(x.dtype)


def rope(x, pos):
    inv = ROPE_THETA ** (-jnp.arange(0, HEAD_DIM, 2, dtype=jnp.float32) / HEAD_DIM)
    ang = pos.astype(jnp.float32)[:, None] * inv[None, :]
    cos = jnp.concatenate([jnp.cos(ang), jnp.cos(ang)], axis=-1)
    sin = jnp.concatenate([jnp.sin(ang), jnp.sin(ang)], axis=-1)
    xf = x.astype(jnp.float32)
    x1, x2 = jnp.split(xf, 2, axis=-1)
    rot = jnp.concatenate([-x2, x1], axis=-1)
    return (xf * cos + rot * sin).astype(x.dtype)


def masked_softmax(s, mask):
    s = jnp.where(mask, s.astype(jnp.float32), -jnp.inf)
    m = jnp.max(s, axis=-1, keepdims=True)
    m = jnp.where(jnp.isfinite(m), m, 0.0)
    p = jnp.exp(s - m)
    d = jnp.sum(p, axis=-1, keepdims=True)
    return p / jnp.where(d > 0, d, 1.0)


def compress(kv, pe, w1, w2):
    B, G, S, D = kv.shape
    r = CMP_BLOCK // CMP_STRIDE
    n = S // CMP_STRIDE - r + 1
    chunks = kv.reshape(B, G, S // CMP_STRIDE, CMP_STRIDE, D)
    blocks = jnp.concatenate([chunks[:, :, j:j + n] for j in range(r)], axis=3)
    h = (blocks + pe).reshape(B, G, n, CMP_BLOCK * D)
    return jax.nn.silu(h @ w1) @ w2


def nsa_attention(q, k_cmp, v_cmp, k_slc, v_slc, k_win, v_win, gates,
                  pe_k, w_k1, w_k2, pe_v, w_v1, w_v2):
    B, S, _ = q.shape
    G, HPG, D = A_GROUPS, A_HPG, HEAD_DIM
    pos = jnp.arange(S)
    q = q.reshape(B, S, G, HPG, D).transpose(0, 2, 3, 1, 4)
    kv_t = lambda a: a.reshape(B, S, G, D).transpose(0, 2, 1, 3)
    k_cmp, v_cmp, k_slc, v_slc, k_win, v_win = (kv_t(a) for a in (k_cmp, v_cmp, k_slc, v_slc, k_win, v_win))
    q_rope = rope(q, pos)
    k_slc = rope(k_slc, pos)
    k_win = rope(k_win, pos)
    kc = compress(k_cmp, pe_k, w_k1, w_k2)
    vc = compress(v_cmp, pe_v, w_v1, w_v2)
    n_cmp = kc.shape[2]
    n_slc = S // SLC_BLOCK
    n_sel = min(SLC_TOP_N, n_slc)
    cmp_start = jnp.arange(n_cmp) * CMP_STRIDE
    cmp_end = cmp_start + CMP_BLOCK - 1
    slc_start = jnp.arange(n_slc) * SLC_BLOCK
    overlap = ((cmp_start[:, None] < slc_start[None, :] + SLC_BLOCK)
               & (cmp_start[:, None] + CMP_BLOCK > slc_start[None, :])).astype(jnp.float32)
    ks_blocks = k_slc.reshape(B, G, n_slc, SLC_BLOCK, D)
    vs_blocks = v_slc.reshape(B, G, n_slc, SLC_BLOCK, D)
    kw_pad = jnp.pad(k_win, ((0, 0), (0, 0), (WINDOW, 0), (0, 0)))
    vw_pad = jnp.pad(v_win, ((0, 0), (0, 0), (WINDOW, 0), (0, 0)))
    gates = jax.nn.sigmoid(gates).reshape(B, S, G, HPG, 3).transpose(0, 2, 3, 1, 4)
    nq = S // Q_BLOCK

    def to_blocks(a):
        a = a.reshape(B, G, HPG, nq, Q_BLOCK, *a.shape[4:])
        return jnp.moveaxis(a, 3, 0)

    scale = HEAD_DIM ** -0.5
    bi = jnp.arange(B)[:, None, None, None]
    gi = jnp.arange(G)[None, :, None, None]
    j_idx = jnp.arange(n_slc)

    def block_fn(args):
        qr, qn, gt, blk = args
        s0 = blk * Q_BLOCK
        t = s0 + jnp.arange(Q_BLOCK)
        sc = jnp.einsum('bghqd,bgnd->bghqn', qn, kc) * scale
        pc = masked_softmax(sc, cmp_end[None, :] <= t[:, None])
        o_cmp = jnp.einsum('bghqn,bgnd->bghqd', pc.astype(vc.dtype), vc)
        imp = jnp.einsum('bghqn,nj->bgqj', pc, overlap)
        cur = (t // SLC_BLOCK)[:, None]
        forced = (j_idx[None, :] == 0) | (j_idx[None, :] == cur) | (j_idx[None, :] == cur - 1)
        imp = jnp.where(j_idx[None, :] > cur, -jnp.inf, jnp.where(forced, FORCE_SCORE, imp))
        top_s, top_i = lax.top_k(imp, n_sel)
        ksel = ks_blocks[bi, gi, top_i]
        vsel = vs_blocks[bi, gi, top_i]
        kpos = top_i[..., None] * SLC_BLOCK + jnp.arange(SLC_BLOCK)
        msel = jnp.isfinite(top_s)[..., None] & (kpos <= t[:, None, None])
        L = n_sel * SLC_BLOCK
        ksel = ksel.reshape(B, G, Q_BLOCK, L, D)
        vsel = vsel.reshape(B, G, Q_BLOCK, L, D)
        msel = msel.reshape(B, G, Q_BLOCK, L)
        ss = jnp.einsum('bghqd,bgqld->bghql', qr, ksel) * scale
        ps = masked_softmax(ss, msel[:, :, None])
        o_slc = jnp.einsum('bghql,bgqld->bghqd', ps.astype(vsel.dtype), vsel)
        kw = lax.dynamic_slice_in_dim(kw_pad, s0, WINDOW + Q_BLOCK, axis=2)
        vw = lax.dynamic_slice_in_dim(vw_pad, s0, WINDOW + Q_BLOCK, axis=2)
        kp = s0 - WINDOW + jnp.arange(WINDOW + Q_BLOCK)
        mw = (kp[None, :] <= t[:, None]) & (kp[None, :] > t[:, None] - WINDOW) & (kp[None, :] >= 0)
        sw = jnp.einsum('bghqd,bgkd->bghqk', qr, kw) * scale
        pw = masked_softmax(sw, mw)
        o_win = jnp.einsum('bghqk,bgkd->bghqd', pw.astype(vw.dtype), vw)
        return gt[..., 0:1] * o_cmp + gt[..., 1:2] * o_slc + gt[..., 2:3] * o_win

    out = lax.map(block_fn, (to_blocks(q_rope), to_blocks(q), to_blocks(gates), jnp.arange(nq)))
    return out.transpose(1, 0, 4, 2, 3, 5).reshape(B, S, A_WIDTH)


def hgrn2(q, f, i, lb):
    B, S, _ = q.shape
    H, DK, DV, C = B_HEADS, B_KDIM, B_VDIM, CHUNK
    n = S // C
    qf = jax.nn.silu(q.astype(jnp.float32))
    fg = lb + (1.0 - lb) * jax.nn.sigmoid(f.astype(jnp.float32))
    logf = jnp.log(fg)
    k = 1.0 - fg
    to_c = lambda a, d: a.reshape(B, n, C, H, d).transpose(0, 3, 1, 2, 4)
    qf, logf, k = to_c(qf, DK), to_c(logf, DK), to_c(k, DK)
    v = to_c(i.astype(jnp.float32), DV)
    b = jnp.cumsum(logf, axis=3)
    b_last = b[..., -1:, :]
    qe = qf * jnp.exp(b)
    ke = k * jnp.exp(-b)
    kd = k * jnp.exp(b_last - b)
    dl = jnp.exp(b_last[..., 0, :])
    causal = jnp.tril(jnp.ones((C, C), dtype=bool))
    attn = jnp.where(causal, jnp.einsum('bhncd,bhnsd->bhncs', qe, ke), 0.0)
    o_intra = jnp.einsum('bhncs,bhnse->bhnce', attn, v)

    def step(state, inp):
        qe_n, kd_n, v_n, dl_n = inp
        o = jnp.einsum('bhcd,bhde->bhce', qe_n, state)
        state = dl_n[..., None] * state + jnp.einsum('bhcd,bhce->bhde', kd_n, v_n)
        return state, o

    xs = (jnp.moveaxis(qe, 2, 0), jnp.moveaxis(kd, 2, 0), jnp.moveaxis(v, 2, 0), jnp.moveaxis(dl, 2, 0))
    s0 = jnp.zeros((B, H, DK, DV), jnp.float32)
    _, o_inter = lax.scan(step, s0, xs)
    o = o_intra + jnp.moveaxis(o_inter, 0, 2)
    return o.transpose(0, 2, 3, 1, 4).reshape(B, S, H, DV)


def setup_inputs(seed: int = 0) -> dict:
    key = jax.random.key(seed)
    ks = jax.random.split(key, 20)
    beta = (8 * DEPTH) ** -0.25
    nrm = lambda k, shape, s: jax.random.normal(k, shape, jnp.float32) * s
    return {
        "x": nrm(ks[0], (BATCH, SEQ, D_MODEL), 1.0),
        "w_in": nrm(ks[1], (DEPTH, D_MODEL, IN_WIDTH), D_MODEL ** -0.5),
        "b_in": nrm(ks[2], (DEPTH, IN_WIDTH), 0.01),
        "pe_cmp_k": nrm(ks[3], (DEPTH, CMP_BLOCK, HEAD_DIM), 0.1),
        "w_cmp_k1": nrm(ks[4], (DEPTH, CMP_BLOCK * HEAD_DIM, CMP_HIDDEN), (CMP_BLOCK * HEAD_DIM) ** -0.5),
        "w_cmp_k2": nrm(ks[5], (DEPTH, CMP_HIDDEN, HEAD_DIM), CMP_HIDDEN ** -0.5),
        "pe_cmp_v": nrm(ks[6], (DEPTH, CMP_BLOCK, HEAD_DIM), 0.1),
        "w_cmp_v1": nrm(ks[7], (DEPTH, CMP_BLOCK * HEAD_DIM, CMP_HIDDEN), (CMP_BLOCK * HEAD_DIM) ** -0.5),
        "w_cmp_v2": nrm(ks[8], (DEPTH, CMP_HIDDEN, HEAD_DIM), CMP_HIDDEN ** -0.5),
        "hgrn_lb_logits": nrm(ks[9], (DEPTH + 1, B_FWIDTH), 0.1),
        "hgrn_norm_g": 1.0 + nrm(ks[10], (DEPTH, B_WIDTH), 0.01),
        "w_branch_a": nrm(ks[11], (DEPTH, A_WIDTH, D_MODEL), beta * A_WIDTH ** -0.5),
        "w_branch_b": nrm(ks[12], (DEPTH, B_WIDTH, D_MODEL), beta * B_WIDTH ** -0.5),
        "w_out": nrm(ks[13], (DEPTH, D_MODEL, D_MODEL), beta * D_MODEL ** -0.5),
        "ln_g": 1.0 + nrm(ks[14], (DEPTH, D_MODEL), 0.01),
        "ln_b": nrm(ks[15], (DEPTH, D_MODEL), 0.01),
    }


def reference(x, w_in, b_in, pe_cmp_k, w_cmp_k1, w_cmp_k2, pe_cmp_v, w_cmp_v1, w_cmp_v2,
              hgrn_lb_logits, hgrn_norm_g, w_branch_a, w_branch_b, w_out, ln_g, ln_b):
    alpha = (2 * DEPTH) ** 0.25
    lb_all = jnp.cumsum(jax.nn.softmax(hgrn_lb_logits.astype(jnp.float32), axis=0), axis=0)
    B, S, _ = x.shape
    for l in range(DEPTH):
        h = x @ w_in[l] + b_in[l]
        (q_a, kv_a, g_nsa, z_a, q_b, f_b, i_b, z_b, gm_a, gm_b) = jnp.split(h, SPLIT_POINTS, axis=-1)
        k_cmp, v_cmp, k_slc, v_slc, k_win, v_win = jnp.split(kv_a, 6, axis=-1)
        o_a = nsa_attention(q_a, k_cmp, v_cmp, k_slc, v_slc, k_win, v_win, g_nsa,
                            pe_cmp_k[l], w_cmp_k1[l], w_cmp_k2[l], pe_cmp_v[l], w_cmp_v1[l], w_cmp_v2[l])
        o_a = o_a * jax.nn.silu(z_a)
        o_b = hgrn2(q_b, f_b, i_b, lb_all[l])
        o_b = o_b * lax.rsqrt(jnp.mean(jnp.square(o_b), axis=-1, keepdims=True) + NORM_EPS)
        o_b = (o_b.reshape(B, S, B_WIDTH) * hgrn_norm_g[l].astype(jnp.float32)).astype(x.dtype)
        o_b = o_b * jax.nn.silu(z_b)
        y = jax.nn.sigmoid(gm_a) * (o_a @ w_branch_a[l]) + jax.nn.sigmoid(gm_b) * (o_b @ w_branch_b[l])
        x = layer_norm(alpha * x + y @ w_out[l], ln_g[l], ln_b[l])
    return x
```

```cpp
#include <hip/hip_runtime.h>
#include <hip/hip_cooperative_groups.h>
#include <cstdio>
#include <cstdint>
namespace cg = cooperative_groups;
namespace pg8 {
#define PG8_LAS __attribute__((address_space(3)))
typedef unsigned short bf16_t;
typedef short bf16x8 __attribute__((ext_vector_type(8)));
typedef float f32x4 __attribute__((ext_vector_type(4)));
typedef unsigned u32x4 __attribute__((ext_vector_type(4)));
constexpr int BM = 256, BK = 64, HALF = 128, HTB = HALF * BK * 2  , STAGE_BYTES = 8 * HTB, NXCD = 8, WGM = 8;

__host__ __device__ __forceinline__ int lds_byte(int r, int c) { const int st = (r >> 4) * 2 + (c >> 5), rr = r & 15, cc = c & 31, ob = rr * 64 + cc * 2; return st * 1024 + (ob ^ (((ob >> 9) & 1) << 5)); }
__host__ __device__ __forceinline__ void stage_rc(int b, int& R, int& C) { const int st = b / 1024, sb = b % 1024, swz = sb ^ (((sb >> 9) & 1) << 5); R = (st >> 1) * 16 + swz / 64; C = (st & 1) * 32 + (swz % 64) / 2; }
__host__ __device__ __forceinline__ int perm32(int rho) { const int n = rho >> 4, i = rho & 15; return 8 * (i >> 2) + 4 * n + (i & 3); }

struct Unit { int pm, pn; };
struct Gemm { const bf16_t* A; const bf16_t* Bt; int M, N, K; };

struct StaticOrder {
    int nM, nN, nwg, G, c;
    __host__ __device__ void init(int M, int N, int G_, int c_) { nM = M / BM; nN = N / BM; nwg = nM * nN; G = G_; c = c_; }
    __host__ __device__ bool next(int i, Unit& u) const {
        const long L = (long)i * G + c; if (L >= nwg) return false;
        int wgid = (int)L; { const int q = nwg / NXCD, r = nwg % NXCD, xcd = wgid % NXCD, off = wgid / NXCD; wgid = (xcd < r ? xcd * (q + 1) : r * (q + 1) + (xcd - r) * q) + off; }
        const int nig = WGM * nN, gid = wgid / nig, fm = gid * WGM, gsz = (nM - fm) < WGM ? (nM - fm) : WGM;
        u.pm = fm + ((wgid % nig) % gsz); u.pn = (wgid % nig) / gsz; return true;
    }
    __device__ __forceinline__ void a_ready(const Unit&) const {}
    __device__ __forceinline__ void done(const Unit&) const {}
};

typedef float f32x2_t_ __attribute__((ext_vector_type(2))); typedef __bf16 bf16x2_t_ __attribute__((ext_vector_type(2)));
__device__ __forceinline__ unsigned cvt_pk_bf16(float lo, float hi) { f32x2_t_ v = {lo, hi}; bf16x2_t_ b = __builtin_convertvector(v, bf16x2_t_); return __builtin_bit_cast(unsigned, b); }
typedef float f32x2 __attribute__((ext_vector_type(2)));
template <class Epi, class Sched, bool ALIGN_EPI = false, bool SP2 = false>
__device__ __forceinline__ void gemm_phase(PG8_LAS unsigned char* lds, const Gemm g, const Sched& S, const Epi& E) {
    const int tid = threadIdx.x, wid = __builtin_amdgcn_readfirstlane(tid >> 6), lane = tid & 63, wr = wid >> 2, wc = wid & 3, fr = lane & 15, fq = lane >> 4;
    const int K = g.K, nt = K / BK;
    unsigned voffA[2], voffB[2];
#pragma unroll
    for (int i = 0; i < 2; ++i) { int R, C; stage_rc(tid * 16 + i * 8192, R, C); const int Rb = Epi::PERM ? ((R & ~31) + perm32(R & 31)) : R;
        voffA[i] = (unsigned)(R * K + C) * 2u; voffB[i] = (unsigned)(Rb * K + C) * 2u; }
    const size_t kstep = (size_t)(BK * 2);
    const size_t hstep = (size_t)HALF * K * 2;
    const size_t tstep = 2 * hstep;
    const unsigned ldsw = (unsigned)wid * 1024u;
    const int aoff = lds_byte(wr * 64 + fr, fq * 8), boff = lds_byte(wc * 32 + fr, fq * 8);
#define PG8_SA(b, h) (((b) * 2 + (h)) * HTB)
#define PG8_SB(b, h) ((4 + (b) * 2 + (h)) * HTB)
#define PG8_STAGE(bufoff, gbase, voff) do { _Pragma("unroll") for (int _i = 0; _i < 2; ++_i) \
        __builtin_amdgcn_global_load_lds((const unsigned*)((const char*)(gbase) + (voff)[_i]), (PG8_LAS unsigned*)(lds + (bufoff) + ldsw + _i * 8192), 16, 0, 0); } while (0)
#define PG8_LDA(dst, b, h) do { _Pragma("unroll") for (int m = 0; m < 4; ++m) _Pragma("unroll") for (int k = 0; k < 2; ++k) dst[m][k] = *(const PG8_LAS bf16x8*)(lds + PG8_SA(b, h) + aoff + m * 2048 + k * 1024); } while (0)
#define PG8_LDB(dst, b, h) do { _Pragma("unroll") for (int n = 0; n < 2; ++n) _Pragma("unroll") for (int k = 0; k < 2; ++k) dst[n][k] = *(const PG8_LAS bf16x8*)(lds + PG8_SB(b, h) + boff + n * 2048 + k * 1024); } while (0)
#define PG8_MMA(ai, bj, At, Bt) do { __builtin_amdgcn_s_setprio(1); _Pragma("unroll") for (int m = 0; m < 4; ++m) _Pragma("unroll") for (int n = 0; n < 2; ++n) _Pragma("unroll") for (int k = 0; k < 2; ++k) \
        acc[ai][bj][m][n] = __builtin_amdgcn_mfma_f32_16x16x32_bf16(Bt[n][k], At[m][k], acc[ai][bj][m][n], 0, 0, 0); __builtin_amdgcn_s_setprio(0); } while (0)
#define PG8_WAIT_V(n) asm volatile("s_waitcnt vmcnt(" #n ")" ::: "memory")
#define PG8_WAIT_L(n) asm volatile("s_waitcnt lgkmcnt(" #n ")" ::: "memory")
#define PG8_BAR __builtin_amdgcn_s_barrier()
#define PG8_SCHED __builtin_amdgcn_sched_barrier(0)
    Unit cur, nxt; int ui = 0;
    if (!S.next(0, cur)) return;
    f32x4 acc[2][2][4][2];
#pragma unroll
    for (int a = 0; a < 2; ++a)
#pragma unroll
        for (int b = 0; b < 2; ++b)
#pragma unroll
            for (int m = 0; m < 4; ++m)
#pragma unroll
                for (int n = 0; n < 2; ++n) acc[a][b][m][n] = (f32x4){0.f, 0.f, 0.f, 0.f};
    bf16x8 At[4][2], B0[2][2], B1[2][2];
    const char* cA = (const char*)g.A + (size_t)cur.pm * tstep; const char* cB = (const char*)g.Bt + (size_t)cur.pn * tstep;
    S.a_ready(cur);
    if constexpr (SP2) {
        PG8_STAGE(PG8_SB(0, 0), cB, voffB); PG8_STAGE(PG8_SB(0, 1), cB + hstep, voffB); PG8_STAGE(PG8_SA(0, 0), cA, voffA); PG8_STAGE(PG8_SA(0, 1), cA + hstep, voffA);
        if (wr == 1) PG8_BAR;
        PG8_WAIT_V(2); PG8_BAR;
        PG8_STAGE(PG8_SB(1, 0), cB + kstep, voffB); PG8_STAGE(PG8_SA(1, 0), cA + kstep, voffA); PG8_STAGE(PG8_SB(1, 1), cB + hstep + kstep, voffB);
        PG8_WAIT_V(6); PG8_BAR;
    } else {
        PG8_STAGE(PG8_SB(0, 0), cB, voffB); PG8_STAGE(PG8_SA(0, 0), cA, voffA); PG8_STAGE(PG8_SB(0, 1), cB + hstep, voffB); PG8_STAGE(PG8_SA(0, 1), cA + hstep, voffA);
        if (wr == 1) PG8_BAR;
        PG8_WAIT_V(4); PG8_BAR;
        PG8_STAGE(PG8_SB(1, 0), cB + kstep, voffB); PG8_STAGE(PG8_SA(1, 0), cA + kstep, voffA); PG8_STAGE(PG8_SB(1, 1), cB + hstep + kstep, voffB);
        PG8_WAIT_V(6); PG8_BAR;
    }
    for (;;) {
        const bool has_next = S.next(ui + 1, nxt);
        const char* nA = has_next ? (const char*)g.A + (size_t)nxt.pm * tstep : cA; const char* nB = has_next ? (const char*)g.Bt + (size_t)nxt.pn * tstep : cB;
        for (int t = 0; t < nt; t += 2) {
            const bool last = (t == nt - 2);
            const char* a1 = cA + (size_t)(t + 1) * kstep;
            const char* a2 = last ? nA : cA + (size_t)(t + 2) * kstep; const char* b2 = last ? nB : cB + (size_t)(t + 2) * kstep;
            const char* a3 = a2 + kstep; const char* b3 = b2 + kstep;
            if (last && has_next) S.a_ready(nxt);
            if constexpr (SP2) {
            PG8_LDB(B0, 0, 0); PG8_LDB(B1, 0, 1); PG8_SCHED; PG8_LDA(At, 0, 0); PG8_STAGE(PG8_SA(1, 1), a1 + hstep, voffA);
            PG8_WAIT_V(8); PG8_WAIT_L(0); PG8_BAR; PG8_MMA(0, 0, At, B0); PG8_MMA(0, 1, At, B1); PG8_BAR; PG8_SCHED;
            PG8_LDA(At, 0, 1); PG8_STAGE(PG8_SB(0, 0), b2, voffB); PG8_STAGE(PG8_SB(0, 1), b2 + hstep, voffB); PG8_STAGE(PG8_SA(0, 0), a2, voffA);
            PG8_WAIT_V(8); PG8_WAIT_L(0); PG8_BAR; PG8_MMA(1, 0, At, B0); PG8_MMA(1, 1, At, B1); PG8_BAR; PG8_SCHED;
            PG8_LDB(B0, 1, 0); PG8_LDB(B1, 1, 1); PG8_SCHED; PG8_LDA(At, 1, 0); PG8_STAGE(PG8_SA(0, 1), a2 + hstep, voffA);
            PG8_WAIT_V(8); PG8_WAIT_L(0); PG8_BAR; PG8_MMA(0, 0, At, B0); PG8_MMA(0, 1, At, B1); PG8_BAR; PG8_SCHED;
            PG8_LDA(At, 1, 1); PG8_STAGE(PG8_SB(1, 0), b3, voffB); PG8_STAGE(PG8_SB(1, 1), b3 + hstep, voffB); PG8_STAGE(PG8_SA(1, 0), a3, voffA);
            PG8_WAIT_V(8); PG8_WAIT_L(0); PG8_BAR; PG8_MMA(1, 0, At, B0); PG8_MMA(1, 1, At, B1); PG8_BAR; PG8_SCHED;
            } else {
            PG8_LDB(B0, 0, 0); PG8_SCHED; PG8_LDA(At, 0, 0); PG8_STAGE(PG8_SA(1, 1), a1 + hstep, voffA);
            PG8_WAIT_L(8); PG8_BAR; PG8_WAIT_L(0); PG8_MMA(0, 0, At, B0); PG8_BAR; PG8_SCHED;
            PG8_LDB(B1, 0, 1); PG8_STAGE(PG8_SB(0, 0), b2, voffB);
            PG8_BAR; PG8_WAIT_L(0); PG8_MMA(0, 1, At, B1); PG8_BAR;
            PG8_LDA(At, 0, 1); PG8_STAGE(PG8_SA(0, 0), a2, voffA);
            PG8_BAR; PG8_WAIT_L(0); PG8_MMA(1, 0, At, B0); PG8_BAR; PG8_SCHED;
            PG8_STAGE(PG8_SB(0, 1), b2 + hstep, voffB);
            PG8_WAIT_V(6); PG8_BAR; PG8_MMA(1, 1, At, B1); PG8_BAR;
            PG8_LDB(B0, 1, 0); PG8_SCHED; PG8_LDA(At, 1, 0); PG8_STAGE(PG8_SA(0, 1), a2 + hstep, voffA);
            PG8_WAIT_L(8); PG8_BAR; PG8_WAIT_L(0); PG8_MMA(0, 0, At, B0); PG8_BAR; PG8_SCHED;
            PG8_LDB(B1, 1, 1); PG8_STAGE(PG8_SB(1, 0), b3, voffB);
            PG8_BAR; PG8_WAIT_L(0); PG8_MMA(0, 1, At, B1); PG8_BAR;
            PG8_LDA(At, 1, 1); PG8_STAGE(PG8_SA(1, 0), a3, voffA);
            PG8_BAR; PG8_WAIT_L(0); PG8_MMA(1, 0, At, B0); PG8_BAR; PG8_SCHED;
            PG8_STAGE(PG8_SB(1, 1), b3 + hstep, voffB);
            PG8_WAIT_V(6); PG8_BAR; PG8_MMA(1, 1, At, B1); PG8_BAR;
            }
        }
        if constexpr (ALIGN_EPI) { if (wr == 0) PG8_BAR; }
        if constexpr (!Epi::AFTER_DRAIN) { E(acc, cur, wr, wc, fr, fq); S.done(cur); }
        if (!has_next) break;
#pragma unroll
        for (int a = 0; a < 2; ++a)
#pragma unroll
            for (int b = 0; b < 2; ++b)
#pragma unroll
                for (int m = 0; m < 4; ++m)
#pragma unroll
                    for (int n = 0; n < 2; ++n) acc[a][b][m][n] = (f32x4){0.f, 0.f, 0.f, 0.f};
        cur = nxt; cA = nA; cB = nB; ++ui;
        if constexpr (ALIGN_EPI) { if (wr == 1) PG8_BAR; }
    }
    PG8_WAIT_V(0);
    if constexpr (!ALIGN_EPI) { if (wr == 0) PG8_BAR; }
    PG8_BAR;
    if constexpr (Epi::AFTER_DRAIN) { E.fused(acc, cur, wr, wc, fr, fq, lds, wid, lane); S.done(cur); }
#undef PG8_SA
#undef PG8_SB
#undef PG8_STAGE
#undef PG8_LDA
#undef PG8_LDB
#undef PG8_MMA
#undef PG8_WAIT_V
#undef PG8_WAIT_L
#undef PG8_BAR
#undef PG8_SCHED
}
}

constexpr int NB = 8, SEQ = 4096, DM = 1024, T = NB * SEQ;
constexpr int NIN = 5912, NINP = 6144;
constexpr float LN_EPS = 1e-5f;
constexpr size_t MiB = 1u << 20;
constexpr size_t WS_CTL = 0, WS_WIN = 2 * MiB, WS_WA = 14 * MiB, WS_WB = 15 * MiB, WS_WO = 16 * MiB, WS_ROPE = 18 * MiB, WS_KCC = 19 * MiB, WS_MISC = 20 * MiB;
constexpr size_t WS_GATE = 32 * MiB, WS_DL = 35 * MiB, WS_KV = 36 * MiB, WS_XB = 84 * MiB, WS_QN = 148 * MiB, WS_ZA = 180 * MiB, WS_Y = 148 * MiB;
constexpr size_t WS_ZB = 212 * MiB, WS_GMA = 244 * MiB, WS_GMB = 308 * MiB, WS_OA = 372 * MiB, WS_OB = 404 * MiB, WS_FG = 436 * MiB, WS_END = 512 * MiB;
constexpr size_t KV_STRIDE = 8 * MiB;
constexpr size_t OUT_QF = 0, OUT_FB = 32 * MiB, OUT_IB = 64 * MiB;
constexpr size_t MISC_BIASP = 0, MISC_LB = 32768;
constexpr int LDS_BYTES = 147456;

typedef unsigned short bf16_t;
typedef float f32x4 __attribute__((ext_vector_type(4)));
typedef unsigned u32x4 __attribute__((ext_vector_type(4)));
typedef unsigned u32x2 __attribute__((ext_vector_type(2)));
#define LAS __attribute__((address_space(3)))

__device__ __forceinline__ float bf2f(unsigned v) { return __uint_as_float(v << 16); }
__device__ __forceinline__ unsigned f2bf(float f) { unsigned u = __float_as_uint(f); return (u + 0x7fffu + ((u >> 16) & 1u)) >> 16; }
__device__ __forceinline__ unsigned pk2(float lo, float hi) { return f2bf(lo) | (f2bf(hi) << 16); }
__device__ __forceinline__ float sigmoidf_(float x) { return __builtin_amdgcn_rcpf(1.0f + __builtin_amdgcn_exp2f(-1.4426950408889634f * x)); }
__device__ __forceinline__ float siluf_(float x) { return x * sigmoidf_(x); }
__device__ __forceinline__ void unpack8(const u32x4 w, float* f) {
    f[0] = bf2f(w.x & 0xffffu); f[1] = __uint_as_float(w.x & 0xffff0000u); f[2] = bf2f(w.y & 0xffffu); f[3] = __uint_as_float(w.y & 0xffff0000u);
    f[4] = bf2f(w.z & 0xffffu); f[5] = __uint_as_float(w.z & 0xffff0000u); f[6] = bf2f(w.w & 0xffffu); f[7] = __uint_as_float(w.w & 0xffff0000u);
}

__host__ __device__ __forceinline__ int in_colmap(int n) {
    if (n < 1280) { if ((n >= 768 && n < 896) || (n >= 1024 && n < 1152)) { const int w = n & 63; return (n & ~63) + (w >> 1) + 32 * (w & 1); } return n; }
    if (n < 5888) return n + 24;
    if (n < 5912) return 1280 + (n - 5888);
    return -1;
}
__device__ const double ROPE_INVF[32] = {1.0, 0.7498942093324559, 0.5623413251903491, 0.4216965034285822, 0.31622776601683794, 0.23713737056616552, 0.1778279410038923, 0.1333521432163324, 0.1, 0.07498942093324558, 0.05623413251903491, 0.042169650342858224, 0.03162277660168379, 0.023713737056616554, 0.01778279410038923, 0.01333521432163324, 0.01, 0.007498942093324558, 0.005623413251903491, 0.004216965034285823, 0.0031622776601683794, 0.0023713737056616554, 0.0017782794100389228, 0.001333521432163324, 0.001, 0.0007498942093324559, 0.0005623413251903491, 0.00042169650342858224, 0.00031622776601683794, 0.00023713737056616554, 0.00017782794100389227, 0.0001333521432163324};

using pg8::Unit;
struct EpiIn {
    static constexpr bool PERM = true, AFTER_DRAIN = false;
    unsigned char* ws; unsigned char* ob;
    template <int ACT> __device__ __forceinline__ void rows(const f32x4 (&acc)[2][2][4][2], const f32x4 (&bv)[2][2], bf16_t* dst, int ld, int row0) const {
#pragma unroll
        for (int ai = 0; ai < 2; ++ai)
#pragma unroll
            for (int m = 0; m < 4; ++m) { bf16_t* rowp = dst + (size_t)(row0 + ai * 128 + m * 16) * ld;
#pragma unroll
                for (int bj = 0; bj < 2; ++bj) { f32x4 v0 = acc[ai][bj][m][0] + bv[bj][0], v1 = acc[ai][bj][m][1] + bv[bj][1];
                    if (ACT == 1) { for (int i = 0; i < 4; ++i) { v0[i] = siluf_(v0[i]); v1[i] = siluf_(v1[i]); } }
                    if (ACT == 2) { for (int i = 0; i < 4; ++i) { v0[i] = sigmoidf_(v0[i]); v1[i] = sigmoidf_(v1[i]); } }
                    u32x4 w; w.x = pg8::cvt_pk_bf16(v0[0], v0[1]); w.y = pg8::cvt_pk_bf16(v0[2], v0[3]); w.z = pg8::cvt_pk_bf16(v1[0], v1[1]); w.w = pg8::cvt_pk_bf16(v1[2], v1[3]);
                    *(u32x4*)(rowp + bj * 128) = w; } }
    }
    __device__ __forceinline__ void operator()(const f32x4 (&acc)[2][2][4][2], const Unit& u, int wr, int wc, int fr, int fq) const {
        const int pn = u.pn, row0 = u.pm * 256 + wr * 64 + fr, cl0 = wc * 32 + 8 * fq;
        const float* biasp = (const float*)(ws + WS_MISC + MISC_BIASP) + pn * 256 + cl0;
        f32x4 bv[2][2];
#pragma unroll
        for (int bj = 0; bj < 2; ++bj)
#pragma unroll
            for (int n = 0; n < 2; ++n) bv[bj][n] = *(const f32x4*)(biasp + bj * 128 + 4 * n);
        if (pn < 2) { rows<0>(acc, bv, (bf16_t*)(ws + WS_QN) + pn * 256 + cl0, 512, row0); return; }
        if (pn < 5) {
            bf16_t* kb = (bf16_t*)(ws + WS_KV + (size_t)(2 * (pn - 2)) * KV_STRIDE); bf16_t* vb = (bf16_t*)(ws + WS_KV + (size_t)(2 * (pn - 2) + 1) * KV_STRIDE);
            const float* cosT = (const float*)(ws + WS_ROPE); const float* sinT = cosT + 4096 * 32;
            const int g = cl0 >> 6, w = cl0 & 63;
#pragma unroll
            for (int ai = 0; ai < 2; ++ai)
#pragma unroll
                for (int m = 0; m < 4; ++m) { const int r = row0 + ai * 128 + m * 16, b = r >> 12, t = r & 4095; const size_t ro = ((size_t)(b * 2 + g) * 4096 + t) * 64;
                    { f32x4 v0 = acc[ai][0][m][0] + bv[0][0], v1 = acc[ai][0][m][1] + bv[0][1];
                      if (pn > 2) { const int i0 = w >> 1; const f32x4 c = *(const f32x4*)(cosT + t * 32 + i0), s = *(const f32x4*)(sinT + t * 32 + i0);
                          const f32x4 x1 = {v0[0], v0[2], v1[0], v1[2]}, x2 = {v0[1], v0[3], v1[1], v1[3]};
                          const f32x4 lo = x1 * c - x2 * s, hi = x2 * c + x1 * s;
                          u32x2 a, bq; a.x = pg8::cvt_pk_bf16(lo[0], lo[1]); a.y = pg8::cvt_pk_bf16(lo[2], lo[3]); bq.x = pg8::cvt_pk_bf16(hi[0], hi[1]); bq.y = pg8::cvt_pk_bf16(hi[2], hi[3]);
                          *(u32x2*)(kb + ro + i0) = a; *(u32x2*)(kb + ro + 32 + i0) = bq;
                      } else { u32x4 wv; wv.x = pg8::cvt_pk_bf16(v0[0], v0[1]); wv.y = pg8::cvt_pk_bf16(v0[2], v0[3]); wv.z = pg8::cvt_pk_bf16(v1[0], v1[1]); wv.w = pg8::cvt_pk_bf16(v1[2], v1[3]); *(u32x4*)(kb + ro + w) = wv; } }
                    { const f32x4 v0 = acc[ai][1][m][0] + bv[1][0], v1 = acc[ai][1][m][1] + bv[1][1];
                      u32x4 wv; wv.x = pg8::cvt_pk_bf16(v0[0], v0[1]); wv.y = pg8::cvt_pk_bf16(v0[2], v0[3]); wv.z = pg8::cvt_pk_bf16(v1[0], v1[1]); wv.w = pg8::cvt_pk_bf16(v1[2], v1[3]); *(u32x4*)(vb + ro + w) = wv; } }
            return; }
        if (pn < 7)  { rows<1>(acc, bv, (bf16_t*)(ws + WS_ZA) + (pn - 5) * 256 + cl0, 512, row0); return; }
        if (pn < 9)  { rows<1>(acc, bv, (bf16_t*)(ob + OUT_QF) + (pn - 7) * 256 + cl0, 512, row0); return; }
        if (pn < 11) { rows<0>(acc, bv, (bf16_t*)(ob + OUT_FB) + (pn - 9) * 256 + cl0, 512, row0); return; }
        if (pn < 13) { rows<0>(acc, bv, (bf16_t*)(ob + OUT_IB) + (pn - 11) * 256 + cl0, 512, row0); return; }
        if (pn < 15) { rows<1>(acc, bv, (bf16_t*)(ws + WS_ZB) + (pn - 13) * 256 + cl0, 512, row0); return; }
        if (pn < 19) { rows<2>(acc, bv, (bf16_t*)(ws + WS_GMA) + (pn - 15) * 256 + cl0, 1024, row0); return; }
        if (pn < 23) { rows<2>(acc, bv, (bf16_t*)(ws + WS_GMB) + (pn - 19) * 256 + cl0, 1024, row0); return; }
        if (cl0 < 24) {
            float* gt = (float*)(ws + WS_GATE);
#pragma unroll
            for (int ai = 0; ai < 2; ++ai)
#pragma unroll
                for (int m = 0; m < 4; ++m) { const int r = row0 + ai * 128 + m * 16; f32x4 v0 = acc[ai][0][m][0] + bv[0][0], v1 = acc[ai][0][m][1] + bv[0][1];
                    for (int i = 0; i < 4; ++i) { v0[i] = sigmoidf_(v0[i]); v1[i] = sigmoidf_(v1[i]); }
                    *(f32x4*)(gt + (size_t)r * 24 + cl0) = v0; *(f32x4*)(gt + (size_t)r * 24 + cl0 + 4) = v1; } }
    }
};
struct EpiYA {
    static constexpr bool PERM = true, AFTER_DRAIN = false;
    const bf16_t* gate; float* ya;
    __device__ __forceinline__ void operator()(const f32x4 (&acc)[2][2][4][2], const Unit& u, int wr, int wc, int fr, int fq) const {
        const int row0 = u.pm * 256 + wr * 64 + fr, col0 = u.pn * 256 + wc * 32 + 8 * fq;
#pragma unroll
        for (int ai = 0; ai < 2; ++ai)
#pragma unroll
            for (int m = 0; m < 4; ++m)
#pragma unroll
                for (int bj = 0; bj < 2; ++bj) { const size_t off = (size_t)(row0 + ai * 128 + m * 16) * 1024 + col0 + bj * 128;
                    float g[8]; unpack8(*(const u32x4*)(gate + off), g);
                    f32x4 o0 = acc[ai][bj][m][0], o1 = acc[ai][bj][m][1];
                    for (int i = 0; i < 4; ++i) { o0[i] *= g[i]; o1[i] *= g[4 + i]; }
                    *(f32x4*)(ya + off) = o0; *(f32x4*)(ya + off + 4) = o1; }
    }
};
struct EpiYB {
    static constexpr bool PERM = true, AFTER_DRAIN = false;
    const bf16_t* gate; const float* ya; bf16_t* y;
    __device__ __forceinline__ void operator()(const f32x4 (&acc)[2][2][4][2], const Unit& u, int wr, int wc, int fr, int fq) const {
        const int row0 = u.pm * 256 + wr * 64 + fr, col0 = u.pn * 256 + wc * 32 + 8 * fq;
#pragma unroll
        for (int ai = 0; ai < 2; ++ai)
#pragma unroll
            for (int m = 0; m < 4; ++m)
#pragma unroll
                for (int bj = 0; bj < 2; ++bj) { const size_t off = (size_t)(row0 + ai * 128 + m * 16) * 1024 + col0 + bj * 128;
                    float g[8]; unpack8(*(const u32x4*)(gate + off), g);
                    f32x4 o0 = *(const f32x4*)(ya + off), o1 = *(const f32x4*)(ya + off + 4);
                    for (int i = 0; i < 4; ++i) { o0[i] += g[i] * acc[ai][bj][m][0][i]; o1[i] += g[4 + i] * acc[ai][bj][m][1][i]; }
                    u32x4 w; w.x = pg8::cvt_pk_bf16(o0[0], o0[1]); w.y = pg8::cvt_pk_bf16(o0[2], o0[3]); w.z = pg8::cvt_pk_bf16(o1[0], o1[1]); w.w = pg8::cvt_pk_bf16(o1[2], o1[3]);
                    *(u32x4*)(y + off) = w; }
    }
};
struct EpiOut {
    static constexpr bool PERM = true, AFTER_DRAIN = false;
    const float* x; float* out; float alpha;
    __device__ __forceinline__ void operator()(const f32x4 (&acc)[2][2][4][2], const Unit& u, int wr, int wc, int fr, int fq) const {
        const int row0 = u.pm * 256 + wr * 64 + fr, col0 = u.pn * 256 + wc * 32 + 8 * fq;
#pragma unroll
        for (int ai = 0; ai < 2; ++ai)
#pragma unroll
            for (int m = 0; m < 4; ++m)
#pragma unroll
                for (int bj = 0; bj < 2; ++bj) { const size_t off = (size_t)(row0 + ai * 128 + m * 16) * 1024 + col0 + bj * 128;
                    const f32x4 x0 = *(const f32x4*)(x + off), x1 = *(const f32x4*)(x + off + 4);
                    *(f32x4*)(out + off) = x0 * alpha + acc[ai][bj][m][0]; *(f32x4*)(out + off + 4) = x1 * alpha + acc[ai][bj][m][1]; }
    }
};

template <class CMap> __device__ __forceinline__ void transpose_item(const float* W, int K, int ldw, int Nn, bf16_t* WT, LAS float* scr, int item, int lane, const CMap& cmap) {
    const int nblk = Nn / 32, kb = item / nblk, nb = item % nblk, k0 = 64 * kb, n0 = 32 * nb;
    const int oc = cmap(n0 + (lane & 31));
#pragma unroll 8
    for (int i = 0; i < 32; ++i) { const int kk = 2 * i + (lane >> 5); scr[kk * 33 + (lane & 31)] = oc >= 0 ? W[(size_t)(k0 + kk) * ldw + oc] : 0.f; }
    asm volatile("s_waitcnt lgkmcnt(0)" ::: "memory");
    const int c = lane & 7;
#pragma unroll
    for (int j = 0; j < 4; ++j) { const int n = (lane >> 3) + 8 * j; const LAS float* s = scr + (8 * c) * 33 + n;
        u32x4 o; o.x = pk2(s[0 * 33], s[1 * 33]); o.y = pk2(s[2 * 33], s[3 * 33]); o.z = pk2(s[4 * 33], s[5 * 33]); o.w = pk2(s[6 * 33], s[7 * 33]);
        *(u32x4*)(WT + (size_t)(n0 + n) * K + k0 + 8 * c) = o; }
    asm volatile("s_waitcnt lgkmcnt(0)" ::: "memory");
}
struct CMapIn { __device__ __forceinline__ int operator()(int n) const { return in_colmap(n); } };
struct CMapId { __device__ __forceinline__ int operator()(int n) const { return n; } };

struct Args { const float* in[16]; float* out; unsigned char* ws; int ph_lo, ph_hi; };
enum { I_X = 0, I_WIN, I_BIN, I_PEK, I_WK1, I_WK2, I_PEV, I_WV1, I_WV2, I_LB, I_HG, I_WA, I_WB, I_WO, I_LNG, I_LNB };

__global__ void __launch_bounds__(512, 2) mega(Args a) {
    extern __shared__ __attribute__((aligned(16))) unsigned char lds_raw[];
    LAS unsigned char* lds = (LAS unsigned char*)lds_raw;
    const int tid = threadIdx.x, lane = tid & 63, wave = __builtin_amdgcn_readfirstlane(tid >> 6);
    const int G = gridDim.x, bx = blockIdx.x;
    const int gw = bx * 8 + wave, NGW = G * 8;
    unsigned char* ws = a.ws; unsigned char* ob = (unsigned char*)a.out;
    const int lo = a.ph_lo, hi = a.ph_hi;
#define IN(k) (lo <= (k) && (k) < hi)
#define SEAM(k) do { if (IN(k) && IN((k) + 1)) { cg::this_grid().sync(); } } while (0)
    if (IN(0)) {
        LAS float* scr = (LAS float*)(lds + wave * 16384);
        constexpr int NI_IN = 16 * (NINP / 32), NI_A = 8 * 32, NI_O = 16 * 32, NITEMS = NI_IN + 2 * NI_A + NI_O;
        for (int it = gw; it < NITEMS; it += NGW) {
            int r = it;
            if (r < NI_IN) { transpose_item(a.in[I_WIN], 1024, NIN, NINP, (bf16_t*)(ws + WS_WIN), scr, r, lane, CMapIn()); continue; } r -= NI_IN;
            if (r < NI_A) { transpose_item(a.in[I_WA], 512, 1024, 1024, (bf16_t*)(ws + WS_WA), scr, r, lane, CMapId()); continue; } r -= NI_A;
            if (r < NI_A) { transpose_item(a.in[I_WB], 512, 1024, 1024, (bf16_t*)(ws + WS_WB), scr, r, lane, CMapId()); continue; } r -= NI_A;
            transpose_item(a.in[I_WO], 1024, 1024, 1024, (bf16_t*)(ws + WS_WO), scr, r, lane, CMapId());
        }
        for (int m = gw; m < T; m += NGW) { const f32x4* xr = (const f32x4*)(a.in[I_X] + (size_t)m * DM) + lane; u32x2* o8 = (u32x2*)((bf16_t*)(ws + WS_XB) + (size_t)m * DM) + lane;
#pragma unroll
            for (int j = 0; j < 4; ++j) { const f32x4 v = xr[64 * j]; u32x2 o; o.x = pk2(v.x, v.y); o.y = pk2(v.z, v.w); o8[64 * j] = o; } }
        const int gt = bx * 512 + tid, NGT = G * 512;
        float* cosT = (float*)(ws + WS_ROPE); float* sinT = cosT + 4096 * 32;
        for (int i = gt; i < 4096 * 32; i += NGT) { const int pos = i >> 5, k = i & 31; const double rev = (double)pos * ROPE_INVF[k] * 0.15915494309189535; const float fr = (float)(rev - floor(rev));
            cosT[i] = __builtin_amdgcn_cosf(fr); sinT[i] = __builtin_amdgcn_sinf(fr); }
        for (int i = gt; i < NINP; i += NGT) { const int oc = in_colmap(i); ((float*)(ws + WS_MISC + MISC_BIASP))[i] = oc >= 0 ? a.in[I_BIN][oc] : 0.f; }
        for (int i = gt; i < 512; i += NGT) { const float l0 = a.in[I_LB][i], l1 = a.in[I_LB][512 + i]; ((float*)(ws + WS_MISC + MISC_LB))[i] = 1.0f / (1.0f + expf(l1 - l0)); }
    }
    SEAM(0);
    if (IN(1)) {
        pg8::Gemm g{(const bf16_t*)(ws + WS_XB), (const bf16_t*)(ws + WS_WIN), T, NINP, DM}; pg8::StaticOrder S; S.init(T, NINP, G, bx);
        EpiIn E{ws, ob};
        pg8::gemm_phase<EpiIn, pg8::StaticOrder, true, true>(lds, g, S, E);
    }
    SEAM(1);
    if (IN(5)) {
        { pg8::Gemm g{(const bf16_t*)(ws + WS_OA), (const bf16_t*)(ws + WS_WA), T, DM, 512}; pg8::StaticOrder S; S.init(T, DM, G, bx);
          EpiYA E{(const bf16_t*)(ws + WS_GMA), a.out};
          pg8::gemm_phase<EpiYA, pg8::StaticOrder, true, true>(lds, g, S, E); }
        __syncthreads();
        { pg8::Gemm g{(const bf16_t*)(ws + WS_OB), (const bf16_t*)(ws + WS_WB), T, DM, 512}; pg8::StaticOrder S; S.init(T, DM, G, bx);
          EpiYB E{(const bf16_t*)(ws + WS_GMB), a.out, (bf16_t*)(ws + WS_Y)};
          pg8::gemm_phase<EpiYB, pg8::StaticOrder, true, true>(lds, g, S, E); }
    }
    SEAM(5);
    if (IN(6)) {
        pg8::Gemm g{(const bf16_t*)(ws + WS_Y), (const bf16_t*)(ws + WS_WO), T, DM, DM}; pg8::StaticOrder S; S.init(T, DM, G, bx);
        EpiOut E{a.in[I_X], a.out, 1.189207115002721f};
        pg8::gemm_phase<EpiOut, pg8::StaticOrder, true, true>(lds, g, S, E);
    }
    SEAM(6);
    if (IN(7)) {
        const f32x4* gp = (const f32x4*)a.in[I_LNG] + lane; const f32x4* bp = (const f32x4*)a.in[I_LNB] + lane;
        for (int m = gw; m < T; m += NGW) { f32x4* xr = (f32x4*)(a.out + (size_t)m * DM) + lane;
            f32x4 v[4]; float s = 0.f;
#pragma unroll
            for (int j = 0; j < 4; ++j) { v[j] = xr[64 * j]; s += (v[j].x + v[j].y) + (v[j].z + v[j].w); }
#pragma unroll
            for (int o = 1; o < 64; o <<= 1) s += __shfl_xor(s, o);
            const float mean = s * (1.f / DM); float s2 = 0.f;
#pragma unroll
            for (int j = 0; j < 4; ++j) { v[j] = v[j] - mean; s2 += (v[j].x * v[j].x + v[j].y * v[j].y) + (v[j].z * v[j].z + v[j].w * v[j].w); }
#pragma unroll
            for (int o = 1; o < 64; o <<= 1) s2 += __shfl_xor(s2, o);
            const float rstd = 1.f / sqrtf(s2 * (1.f / DM) + LN_EPS);
#pragma unroll
            for (int j = 0; j < 4; ++j) xr[64 * j] = v[j] * rstd * gp[64 * j] + bp[64 * j]; }
    }
#undef IN
#undef SEAM
}

__global__ void __launch_bounds__(128) k_compress_naive(Args a) {
    __shared__ float inb[2048]; __shared__ float hb[128];
    const int n = blockIdx.x, bg = blockIdx.y, kv = blockIdx.z, tid = threadIdx.x;
    const bf16_t* src = (const bf16_t*)(a.ws + WS_KV + (size_t)kv * KV_STRIDE) + ((size_t)bg * 4096 + 16 * n) * 64;
    const float* pe = a.in[kv ? I_PEV : I_PEK]; const float* w1 = a.in[kv ? I_WV1 : I_WK1]; const float* w2 = a.in[kv ? I_WV2 : I_WK2];
    for (int i = tid; i < 2048; i += 128) inb[i] = bf2f(src[i]) + pe[i];
    __syncthreads();
    float acc = 0.f;
    for (int i = 0; i < 2048; ++i) acc += inb[i] * w1[(size_t)i * 128 + tid];
    hb[tid] = siluf_(acc);
    __syncthreads();
    if (tid < 64) { float o = 0.f; for (int j = 0; j < 128; ++j) o += hb[j] * w2[j * 64 + tid];
        ((bf16_t*)(a.ws + WS_KCC + (size_t)kv * (MiB / 2)))[((size_t)bg * 256 + n) * 64 + tid] = (bf16_t)f2bf(o); }
}
__global__ void __launch_bounds__(256) k_fg_naive(Args a) {
    const size_t i = (size_t)blockIdx.x * 256 + threadIdx.x; const int c = (int)(i & 511);
    const float lb = ((const float*)(a.ws + WS_MISC + MISC_LB))[c];
    const float f = bf2f(((const bf16_t*)((unsigned char*)a.out + OUT_FB))[i]);
    ((float*)(a.ws + WS_FG))[i] = lb + (1.f - lb) * sigmoidf_(f);
}
__global__ void __launch_bounds__(128) k_hgrn_naive(Args a) {
    __shared__ float red[2][2];
    const int b = blockIdx.x >> 2, h = blockIdx.x & 3, dv = threadIdx.x, lane = dv & 63, wv = dv >> 6;
    const float* FG = (const float*)(a.ws + WS_FG); const bf16_t* QF = (const bf16_t*)((unsigned char*)a.out + OUT_QF); const bf16_t* IB = (const bf16_t*)((unsigned char*)a.out + OUT_IB);
    const bf16_t* ZB = (const bf16_t*)(a.ws + WS_ZB); bf16_t* OB = (bf16_t*)(a.ws + WS_OB);
    const float gn = a.in[I_HG][h * 128 + dv];
    float S[128];
#pragma unroll
    for (int i = 0; i < 128; ++i) S[i] = 0.f;
    for (int t = 0; t < SEQ; ++t) {
        const size_t ro = ((size_t)b * SEQ + t) * 512 + h * 128;
        const float v = bf2f(IB[ro + dv]);
        float o = 0.f;
#pragma unroll
        for (int dk = 0; dk < 128; ++dk) { const float fg = FG[ro + dk]; const float q = bf2f(QF[ro + dk]); S[dk] = fg * S[dk] + (1.f - fg) * v; o += q * S[dk]; }
        float ss = o * o;
#pragma unroll
        for (int of = 1; of < 64; of <<= 1) ss += __shfl_xor(ss, of);
        if (lane == 0) red[t & 1][wv] = ss;
        __syncthreads();
        const float tot = red[t & 1][0] + red[t & 1][1];
        const float ov = o * (1.0f / sqrtf(tot * (1.f / 128.f) + LN_EPS)) * gn * bf2f(ZB[ro + dv]);
        OB[ro + dv] = (bf16_t)f2bf(ov);
    }
}
__device__ __forceinline__ void load_row64(const bf16_t* p, float* f) {
#pragma unroll
    for (int c = 0; c < 8; ++c) unpack8(*(const u32x4*)(p + 8 * c), f + 8 * c);
}
__global__ void __launch_bounds__(256) k_nsa_naive(Args a) {
    __shared__ float imp[64][65]; __shared__ unsigned long long sel[64];
    const int qt = blockIdx.x, bg = blockIdx.y, b = bg >> 1, g = bg & 1, tid = threadIdx.x, tok = tid >> 2, head = tid & 3;
    const int t = qt * 64 + tok, r = b * SEQ + t, hg = g * 4 + head;
    const bf16_t* KC = (const bf16_t*)(a.ws + WS_KCC) + (size_t)bg * 256 * 64; const bf16_t* VC = (const bf16_t*)(a.ws + WS_KCC + MiB / 2) + (size_t)bg * 256 * 64;
    const bf16_t* KS = (const bf16_t*)(a.ws + WS_KV + 2 * KV_STRIDE) + (size_t)bg * 4096 * 64; const bf16_t* VS = (const bf16_t*)(a.ws + WS_KV + 3 * KV_STRIDE) + (size_t)bg * 4096 * 64;
    const bf16_t* KW = (const bf16_t*)(a.ws + WS_KV + 4 * KV_STRIDE) + (size_t)bg * 4096 * 64; const bf16_t* VW = (const bf16_t*)(a.ws + WS_KV + 5 * KV_STRIDE) + (size_t)bg * 4096 * 64;
    const float* gate = (const float*)(a.ws + WS_GATE) + (size_t)r * 24 + hg * 3;
    float q[64], o[64], out[64], kr[64];
    load_row64((const bf16_t*)(a.ws + WS_QN) + (size_t)r * 512 + hg * 64, q);
#pragma unroll
    for (int d = 0; d < 64; ++d) out[d] = 0.f;
    for (int i = tid; i < 64 * 65; i += 256) (&imp[0][0])[i] = 0.f;
    __syncthreads();
    const int nv = t >= 31 ? ((t - 31) / 16 + 1 > 255 ? 255 : (t - 31) / 16 + 1) : 0;
    const int tl = qt * 64 + 63, nvmax = tl >= 31 ? ((tl - 31) / 16 + 1 > 255 ? 255 : (tl - 31) / 16 + 1) : 0;
    float m = -INFINITY, l = 0.f;
    for (int n = 0; n < nvmax; ++n) { if (n < nv) { load_row64(KC + n * 64, kr); float s = 0.f;
#pragma unroll
            for (int d = 0; d < 64; ++d) s += q[d] * kr[d];
            s *= 0.125f; const float mn = fmaxf(m, s); l = l * __expf(m - mn) + __expf(s - mn); m = mn; } }
#pragma unroll
    for (int d = 0; d < 64; ++d) o[d] = 0.f;
    const float rl = l > 0.f ? 1.f / l : 0.f;
    for (int n = 0; n < nvmax; ++n) { float p = 0.f;
        if (n < nv) { load_row64(KC + n * 64, kr); float s = 0.f;
#pragma unroll
            for (int d = 0; d < 64; ++d) s += q[d] * kr[d];
            p = __expf(s * 0.125f - m) * rl; load_row64(VC + n * 64, kr);
#pragma unroll
            for (int d = 0; d < 64; ++d) o[d] += p * kr[d]; }
        float ps = p + __shfl_xor(p, 1); ps += __shfl_xor(ps, 2);
        if (head == 0 && n < nv) { imp[tok][n >> 2] += ps; if ((n & 3) == 3 && (n >> 2) + 1 < 64) imp[tok][(n >> 2) + 1] += ps; } }
    { const float g0 = gate[0];
#pragma unroll
      for (int d = 0; d < 64; ++d) out[d] += g0 * o[d]; }
    const int cur = qt;
    if (head == 0) { unsigned long long mask = 0ull;
        for (int pick = 0; pick < 16; ++pick) { float best = -INFINITY; int bi = -1;
            for (int j = 0; j <= cur; ++j) { const float v = (j == 0 || j == cur || j == cur - 1) ? 1e30f : imp[tok][j]; if (!((mask >> j) & 1ull) && v > best) { best = v; bi = j; } }
            if (bi < 0) break; mask |= 1ull << bi; }
        sel[tok] = mask; }
    __syncthreads();
    { const float* cosT = (const float*)(a.ws + WS_ROPE) + t * 32; const float* sinT = cosT + 4096 * 32;
#pragma unroll
      for (int i = 0; i < 32; ++i) { const float c = cosT[i], s = sinT[i], x1 = q[i], x2 = q[i + 32]; q[i] = x1 * c - x2 * s; q[i + 32] = x2 * c + x1 * s; } }
    { const unsigned long long mask = sel[tok]; m = -INFINITY; l = 0.f;
#pragma unroll
      for (int d = 0; d < 64; ++d) o[d] = 0.f;
      for (int j = 0; j <= cur; ++j) { if ((mask >> j) & 1ull) { for (int kk = 0; kk < 64; ++kk) { const int kp = j * 64 + kk; if (kp <= t) {
                    load_row64(KS + (size_t)kp * 64, kr); float s = 0.f;
#pragma unroll
                    for (int d = 0; d < 64; ++d) s += q[d] * kr[d];
                    s *= 0.125f; const float mn = fmaxf(m, s), al = __expf(m - mn), p = __expf(s - mn); l = l * al + p; m = mn; load_row64(VS + (size_t)kp * 64, kr);
#pragma unroll
                    for (int d = 0; d < 64; ++d) o[d] = o[d] * al + p * kr[d]; } } } }
      const float g1 = gate[1] * (l > 0.f ? 1.f / l : 0.f);
#pragma unroll
      for (int d = 0; d < 64; ++d) out[d] += g1 * o[d]; }
    { m = -INFINITY; l = 0.f;
#pragma unroll
      for (int d = 0; d < 64; ++d) o[d] = 0.f;
      const int klo = qt * 64 - 511 > 0 ? qt * 64 - 511 : 0, khi = qt * 64 + 63;
      for (int kp = klo; kp <= khi; ++kp) { if (kp <= t && kp > t - 512) {
              load_row64(KW + (size_t)kp * 64, kr); float s = 0.f;
#pragma unroll
              for (int d = 0; d < 64; ++d) s += q[d] * kr[d];
              s *= 0.125f; const float mn = fmaxf(m, s), al = __expf(m - mn), p = __expf(s - mn); l = l * al + p; m = mn; load_row64(VW + (size_t)kp * 64, kr);
#pragma unroll
              for (int d = 0; d < 64; ++d) o[d] = o[d] * al + p * kr[d]; } }
      const float g2 = gate[2] * (l > 0.f ? 1.f / l : 0.f);
#pragma unroll
      for (int d = 0; d < 64; ++d) out[d] += g2 * o[d]; }
    { const bf16_t* za = (const bf16_t*)(a.ws + WS_ZA) + (size_t)r * 512 + hg * 64; bf16_t* oa = (bf16_t*)(a.ws + WS_OA) + (size_t)r * 512 + hg * 64;
      load_row64(za, kr);
#pragma unroll
      for (int c = 0; c < 8; ++c) { u32x4 w; w.x = pk2(out[8 * c] * kr[8 * c], out[8 * c + 1] * kr[8 * c + 1]); w.y = pk2(out[8 * c + 2] * kr[8 * c + 2], out[8 * c + 3] * kr[8 * c + 3]);
          w.z = pk2(out[8 * c + 4] * kr[8 * c + 4], out[8 * c + 5] * kr[8 * c + 5]); w.w = pk2(out[8 * c + 6] * kr[8 * c + 6], out[8 * c + 7] * kr[8 * c + 7]); *(u32x4*)(oa + 8 * c) = w; } }
}

extern "C" void kernel_launch(void* const* d_in, const int* in_sizes, int n_in, void* d_out, int out_size, void* d_ws, size_t ws_size, hipStream_t stream) {
    static int grid = 0;
    if (grid == 0) {
        if (n_in != 16 || in_sizes[0] != T * DM || out_size != T * DM || ws_size < WS_END) { fprintf(stderr, "kernel_launch: unexpected shapes (n_in %d, in0 %d, out %d, ws %zu)\n", n_in, n_in > 0 ? in_sizes[0] : -1, out_size, ws_size); grid = -1; return; }
        int dev = 0, cus = 0;
        if (hipGetDevice(&dev) != hipSuccess || hipDeviceGetAttribute(&cus, hipDeviceAttributeMultiprocessorCount, dev) != hipSuccess) { grid = -1; return; }
        if (hipFuncSetAttribute((const void*)mega, hipFuncAttributeMaxDynamicSharedMemorySize, LDS_BYTES) != hipSuccess) { fprintf(stderr, "kernel_launch: hipFuncSetAttribute failed\n"); grid = -1; return; }
        grid = cus;
    }
    if (grid < 0) return;
    Args a{};
    for (int i = 0; i < 16; ++i) a.in[i] = (const float*)d_in[i];
    a.out = (float*)d_out; a.ws = (unsigned char*)d_ws;
    auto run = [&](int lo, int hi) { a.ph_lo = lo; a.ph_hi = hi; hipLaunchKernelGGL(mega, dim3(grid), dim3(512), LDS_BYTES, stream, a); };
    run(0, 1); run(1, 2);
    a.ph_lo = 0; a.ph_hi = 0;
    hipLaunchKernelGGL(k_compress_naive, dim3(255, 16, 2), dim3(128), 0, stream, a);
    hipLaunchKernelGGL(k_fg_naive, dim3(T * 512 / 256), dim3(256), 0, stream, a);
    hipLaunchKernelGGL(k_hgrn_naive, dim3(32), dim3(128), 0, stream, a);
    hipLaunchKernelGGL(k_nsa_naive, dim3(64, 16), dim3(256), 0, stream, a);
    run(5, 6); run(6, 7); run(7, 8);
}
```

```cpp
#include <hip/hip_runtime.h>
#include <hip/hip_cooperative_groups.h>
#include <cstdio>
#include <cstdint>
namespace cg = cooperative_groups;
namespace pg8 {
#define PG8_LAS __attribute__((address_space(3)))
typedef unsigned short bf16_t;
typedef short bf16x8 __attribute__((ext_vector_type(8)));
typedef float f32x4 __attribute__((ext_vector_type(4)));
typedef unsigned u32x4 __attribute__((ext_vector_type(4)));
constexpr int BM = 256, BK = 64, HALF = 128, HTB = HALF * BK * 2  , STAGE_BYTES = 8 * HTB, NXCD = 8, WGM = 8;

__host__ __device__ __forceinline__ int lds_byte(int r, int c) { const int st = (r >> 4) * 2 + (c >> 5), rr = r & 15, cc = c & 31, ob = rr * 64 + cc * 2; return st * 1024 + (ob ^ (((ob >> 9) & 1) << 5)); }
__host__ __device__ __forceinline__ void stage_rc(int b, int& R, int& C) { const int st = b / 1024, sb = b % 1024, swz = sb ^ (((sb >> 9) & 1) << 5); R = (st >> 1) * 16 + swz / 64; C = (st & 1) * 32 + (swz % 64) / 2; }
__host__ __device__ __forceinline__ int perm32(int rho) { const int n = rho >> 4, i = rho & 15; return 8 * (i >> 2) + 4 * n + (i & 3); }

struct Unit { int pm, pn; };
struct Gemm { const bf16_t* A; const bf16_t* Bt; int M, N, K; };

struct StaticOrder {
    int nM, nN, nwg, G, c;
    __host__ __device__ void init(int M, int N, int G_, int c_) { nM = M / BM; nN = N / BM; nwg = nM * nN; G = G_; c = c_; }
    __host__ __device__ bool next(int i, Unit& u) const {
        const long L = (long)i * G + c; if (L >= nwg) return false;
        int wgid = (int)L; { const int q = nwg / NXCD, r = nwg % NXCD, xcd = wgid % NXCD, off = wgid / NXCD; wgid = (xcd < r ? xcd * (q + 1) : r * (q + 1) + (xcd - r) * q) + off; }
        const int nig = WGM * nN, gid = wgid / nig, fm = gid * WGM, gsz = (nM - fm) < WGM ? (nM - fm) : WGM;
        u.pm = fm + ((wgid % nig) % gsz); u.pn = (wgid % nig) / gsz; return true;
    }
    __device__ __forceinline__ void a_ready(const Unit&) const {}
    __device__ __forceinline__ void done(const Unit&) const {}
};

typedef float f32x2_t_ __attribute__((ext_vector_type(2))); typedef __bf16 bf16x2_t_ __attribute__((ext_vector_type(2)));
__device__ __forceinline__ unsigned cvt_pk_bf16(float lo, float hi) { f32x2_t_ v = {lo, hi}; bf16x2_t_ b = __builtin_convertvector(v, bf16x2_t_); return __builtin_bit_cast(unsigned, b); }
typedef float f32x2 __attribute__((ext_vector_type(2)));
template <class Epi, class Sched, bool ALIGN_EPI = false, bool SP2 = false>
__device__ __forceinline__ void gemm_phase(PG8_LAS unsigned char* lds, const Gemm g, const Sched& S, const Epi& E) {
    const int tid = threadIdx.x, wid = __builtin_amdgcn_readfirstlane(tid >> 6), lane = tid & 63, wr = wid >> 2, wc = wid & 3, fr = lane & 15, fq = lane >> 4;
    const int K = g.K, nt = K / BK;
    unsigned voffA[2], voffB[2];
#pragma unroll
    for (int i = 0; i < 2; ++i) { int R, C; stage_rc(tid * 16 + i * 8192, R, C); const int Rb = Epi::PERM ? ((R & ~31) + perm32(R & 31)) : R;
        voffA[i] = (unsigned)(R * K + C) * 2u; voffB[i] = (unsigned)(Rb * K + C) * 2u; }
    const size_t kstep = (size_t)(BK * 2);
    const size_t hstep = (size_t)HALF * K * 2;
    const size_t tstep = 2 * hstep;
    const unsigned ldsw = (unsigned)wid * 1024u;
    const int aoff = lds_byte(wr * 64 + fr, fq * 8), boff = lds_byte(wc * 32 + fr, fq * 8);
#define PG8_SA(b, h) (((b) * 2 + (h)) * HTB)
#define PG8_SB(b, h) ((4 + (b) * 2 + (h)) * HTB)
#define PG8_STAGE(bufoff, gbase, voff) do { _Pragma("unroll") for (int _i = 0; _i < 2; ++_i) \
        __builtin_amdgcn_global_load_lds((const unsigned*)((const char*)(gbase) + (voff)[_i]), (PG8_LAS unsigned*)(lds + (bufoff) + ldsw + _i * 8192), 16, 0, 0); } while (0)
#define PG8_LDA(dst, b, h) do { _Pragma("unroll") for (int m = 0; m < 4; ++m) _Pragma("unroll") for (int k = 0; k < 2; ++k) dst[m][k] = *(const PG8_LAS bf16x8*)(lds + PG8_SA(b, h) + aoff + m * 2048 + k * 1024); } while (0)
#define PG8_LDB(dst, b, h) do { _Pragma("unroll") for (int n = 0; n < 2; ++n) _Pragma("unroll") for (int k = 0; k < 2; ++k) dst[n][k] = *(const PG8_LAS bf16x8*)(lds + PG8_SB(b, h) + boff + n * 2048 + k * 1024); } while (0)
#define PG8_MMA(ai, bj, At, Bt) do { __builtin_amdgcn_s_setprio(1); _Pragma("unroll") for (int m = 0; m < 4; ++m) _Pragma("unroll") for (int n = 0; n < 2; ++n) _Pragma("unroll") for (int k = 0; k < 2; ++k) \
        acc[ai][bj][m][n] = __builtin_amdgcn_mfma_f32_16x16x32_bf16(Bt[n][k], At[m][k], acc[ai][bj][m][n], 0, 0, 0); __builtin_amdgcn_s_setprio(0); } while (0)
#define PG8_WAIT_V(n) asm volatile("s_waitcnt vmcnt(" #n ")" ::: "memory")
#define PG8_WAIT_L(n) asm volatile("s_waitcnt lgkmcnt(" #n ")" ::: "memory")
#define PG8_BAR __builtin_amdgcn_s_barrier()
#define PG8_SCHED __builtin_amdgcn_sched_barrier(0)
    Unit cur, nxt; int ui = 0;
    if (!S.next(0, cur)) return;
    f32x4 acc[2][2][4][2];
#pragma unroll
    for (int a = 0; a < 2; ++a)
#pragma unroll
        for (int b = 0; b < 2; ++b)
#pragma unroll
            for (int m = 0; m < 4; ++m)
#pragma unroll
                for (int n = 0; n < 2; ++n) acc[a][b][m][n] = (f32x4){0.f, 0.f, 0.f, 0.f};
    bf16x8 At[4][2], B0[2][2], B1[2][2];
    const char* cA = (const char*)g.A + (size_t)cur.pm * tstep; const char* cB = (const char*)g.Bt + (size_t)cur.pn * tstep;
    S.a_ready(cur);
    if constexpr (SP2) {
        PG8_STAGE(PG8_SB(0, 0), cB, voffB); PG8_STAGE(PG8_SB(0, 1), cB + hstep, voffB); PG8_STAGE(PG8_SA(0, 0), cA, voffA); PG8_STAGE(PG8_SA(0, 1), cA + hstep, voffA);
        if (wr == 1) PG8_BAR;
        PG8_WAIT_V(2); PG8_BAR;
        PG8_STAGE(PG8_SB(1, 0), cB + kstep, voffB); PG8_STAGE(PG8_SA(1, 0), cA + kstep, voffA); PG8_STAGE(PG8_SB(1, 1), cB + hstep + kstep, voffB);
        PG8_WAIT_V(6); PG8_BAR;
    } else {
        PG8_STAGE(PG8_SB(0, 0), cB, voffB); PG8_STAGE(PG8_SA(0, 0), cA, voffA); PG8_STAGE(PG8_SB(0, 1), cB + hstep, voffB); PG8_STAGE(PG8_SA(0, 1), cA + hstep, voffA);
        if (wr == 1) PG8_BAR;
        PG8_WAIT_V(4); PG8_BAR;
        PG8_STAGE(PG8_SB(1, 0), cB + kstep, voffB); PG8_STAGE(PG8_SA(1, 0), cA + kstep, voffA); PG8_STAGE(PG8_SB(1, 1), cB + hstep + kstep, voffB);
        PG8_WAIT_V(6); PG8_BAR;
    }
    for (;;) {
        const bool has_next = S.next(ui + 1, nxt);
        const char* nA = has_next ? (const char*)g.A + (size_t)nxt.pm * tstep : cA; const char* nB = has_next ? (const char*)g.Bt + (size_t)nxt.pn * tstep : cB;
        for (int t = 0; t < nt; t += 2) {
            const bool last = (t == nt - 2);
            const char* a1 = cA + (size_t)(t + 1) * kstep;
            const char* a2 = last ? nA : cA + (size_t)(t + 2) * kstep; const char* b2 = last ? nB : cB + (size_t)(t + 2) * kstep;
            const char* a3 = a2 + kstep; const char* b3 = b2 + kstep;
            if (last && has_next) S.a_ready(nxt);
            if constexpr (SP2) {
            PG8_LDB(B0, 0, 0); PG8_LDB(B1, 0, 1); PG8_SCHED; PG8_LDA(At, 0, 0); PG8_STAGE(PG8_SA(1, 1), a1 + hstep, voffA);
            PG8_WAIT_V(8); PG8_WAIT_L(0); PG8_BAR; PG8_MMA(0, 0, At, B0); PG8_MMA(0, 1, At, B1); PG8_BAR; PG8_SCHED;
            PG8_LDA(At, 0, 1); PG8_STAGE(PG8_SB(0, 0), b2, voffB); PG8_STAGE(PG8_SB(0, 1), b2 + hstep, voffB); PG8_STAGE(PG8_SA(0, 0), a2, voffA);
            PG8_WAIT_V(8); PG8_WAIT_L(0); PG8_BAR; PG8_MMA(1, 0, At, B0); PG8_MMA(1, 1, At, B1); PG8_BAR; PG8_SCHED;
            PG8_LDB(B0, 1, 0); PG8_LDB(B1, 1, 1); PG8_SCHED; PG8_LDA(At, 1, 0); PG8_STAGE(PG8_SA(0, 1), a2 + hstep, voffA);
            PG8_WAIT_V(8); PG8_WAIT_L(0); PG8_BAR; PG8_MMA(0, 0, At, B0); PG8_MMA(0, 1, At, B1); PG8_BAR; PG8_SCHED;
            PG8_LDA(At, 1, 1); PG8_STAGE(PG8_SB(1, 0), b3, voffB); PG8_STAGE(PG8_SB(1, 1), b3 + hstep, voffB); PG8_STAGE(PG8_SA(1, 0), a3, voffA);
            PG8_WAIT_V(8); PG8_WAIT_L(0); PG8_BAR; PG8_MMA(1, 0, At, B0); PG8_MMA(1, 1, At, B1); PG8_BAR; PG8_SCHED;
            } else {
            PG8_LDB(B0, 0, 0); PG8_SCHED; PG8_LDA(At, 0, 0); PG8_STAGE(PG8_SA(1, 1), a1 + hstep, voffA);
            PG8_WAIT_L(8); PG8_BAR; PG8_WAIT_L(0); PG8_MMA(0, 0, At, B0); PG8_BAR; PG8_SCHED;
            PG8_LDB(B1, 0, 1); PG8_STAGE(PG8_SB(0, 0), b2, voffB);
            PG8_BAR; PG8_WAIT_L(0); PG8_MMA(0, 1, At, B1); PG8_BAR;
            PG8_LDA(At, 0, 1); PG8_STAGE(PG8_SA(0, 0), a2, voffA);
            PG8_BAR; PG8_WAIT_L(0); PG8_MMA(1, 0, At, B0); PG8_BAR; PG8_SCHED;
            PG8_STAGE(PG8_SB(0, 1), b2 + hstep, voffB);
            PG8_WAIT_V(6); PG8_BAR; PG8_MMA(1, 1, At, B1); PG8_BAR;
            PG8_LDB(B0, 1, 0); PG8_SCHED; PG8_LDA(At, 1, 0); PG8_STAGE(PG8_SA(0, 1), a2 + hstep, voffA);
            PG8_WAIT_L(8); PG8_BAR; PG8_WAIT_L(0); PG8_MMA(0, 0, At, B0); PG8_BAR; PG8_SCHED;
            PG8_LDB(B1, 1, 1); PG8_STAGE(PG8_SB(1, 0), b3, voffB);
            PG8_BAR; PG8_WAIT_L(0); PG8_MMA(0, 1, At, B1); PG8_BAR;
            PG8_LDA(At, 1, 1); PG8_STAGE(PG8_SA(1, 0), a3, voffA);
            PG8_BAR; PG8_WAIT_L(0); PG8_MMA(1, 0, At, B0); PG8_BAR; PG8_SCHED;
            PG8_STAGE(PG8_SB(1, 1), b3 + hstep, voffB);
            PG8_WAIT_V(6); PG8_BAR; PG8_MMA(1, 1, At, B1); PG8_BAR;
            }
        }
        if constexpr (ALIGN_EPI) { if (wr == 0) PG8_BAR; }
        if constexpr (!Epi::AFTER_DRAIN) { E(acc, cur, wr, wc, fr, fq); S.done(cur); }
        if (!has_next) break;
#pragma unroll
        for (int a = 0; a < 2; ++a)
#pragma unroll
            for (int b = 0; b < 2; ++b)
#pragma unroll
                for (int m = 0; m < 4; ++m)
#pragma unroll
                    for (int n = 0; n < 2; ++n) acc[a][b][m][n] = (f32x4){0.f, 0.f, 0.f, 0.f};
        cur = nxt; cA = nA; cB = nB; ++ui;
        if constexpr (ALIGN_EPI) { if (wr == 1) PG8_BAR; }
    }
    PG8_WAIT_V(0);
    if constexpr (!ALIGN_EPI) { if (wr == 0) PG8_BAR; }
    PG8_BAR;
    if constexpr (Epi::AFTER_DRAIN) { E.fused(acc, cur, wr, wc, fr, fq, lds, wid, lane); S.done(cur); }
#undef PG8_SA
#undef PG8_SB
#undef PG8_STAGE
#undef PG8_LDA
#undef PG8_LDB
#undef PG8_MMA
#undef PG8_WAIT_V
#undef PG8_WAIT_L
#undef PG8_BAR
#undef PG8_SCHED
}
}

constexpr int NB = 8, SEQ = 4096, DM = 1024, T = NB * SEQ;
constexpr int NIN = 5912, NINP = 6144;
constexpr float LN_EPS = 1e-5f;
constexpr size_t MiB = 1u << 20;
constexpr size_t WS_CTL = 0, WS_WIN = 2 * MiB, WS_WA = 14 * MiB, WS_WB = 15 * MiB, WS_WO = 16 * MiB, WS_ROPE = 18 * MiB, WS_KCC = 19 * MiB, WS_MISC = 20 * MiB;
constexpr size_t WS_GATE = 32 * MiB, WS_DL = 35 * MiB, WS_KV = 36 * MiB, WS_XB = 84 * MiB, WS_QN = 148 * MiB, WS_ZA = 180 * MiB, WS_Y = 148 * MiB;
constexpr size_t WS_ZB = 212 * MiB, WS_GMA = 244 * MiB, WS_GMB = 308 * MiB, WS_OA = 372 * MiB, WS_OB = 404 * MiB, WS_FG = 436 * MiB, WS_END = 512 * MiB;
constexpr size_t KV_STRIDE = 8 * MiB;
constexpr size_t OUT_QF = 0, OUT_FB = 32 * MiB, OUT_IB = 64 * MiB;
constexpr size_t MISC_BIASP = 0, MISC_LB = 32768, MISC_C1 = 40960;
constexpr size_t WS_PP = 22 * MiB, WS_W1T = 30 * MiB;
constexpr int LDS_BYTES = 147456;

typedef unsigned short bf16_t;
typedef float f32x4 __attribute__((ext_vector_type(4)));
typedef unsigned u32x4 __attribute__((ext_vector_type(4)));
typedef unsigned u32x2 __attribute__((ext_vector_type(2)));
#define LAS __attribute__((address_space(3)))

__device__ __forceinline__ float bf2f(unsigned v) { return __uint_as_float(v << 16); }
__device__ __forceinline__ unsigned f2bf(float f) { unsigned u = __float_as_uint(f); return (u + 0x7fffu + ((u >> 16) & 1u)) >> 16; }
__device__ __forceinline__ unsigned pk2(float lo, float hi) { return f2bf(lo) | (f2bf(hi) << 16); }
__device__ __forceinline__ float sigmoidf_(float x) { return __builtin_amdgcn_rcpf(1.0f + __builtin_amdgcn_exp2f(-1.4426950408889634f * x)); }
__device__ __forceinline__ float siluf_(float x) { return x * sigmoidf_(x); }
__device__ __forceinline__ void unpack8(const u32x4 w, float* f) {
    f[0] = bf2f(w.x & 0xffffu); f[1] = __uint_as_float(w.x & 0xffff0000u); f[2] = bf2f(w.y & 0xffffu); f[3] = __uint_as_float(w.y & 0xffff0000u);
    f[4] = bf2f(w.z & 0xffffu); f[5] = __uint_as_float(w.z & 0xffff0000u); f[6] = bf2f(w.w & 0xffffu); f[7] = __uint_as_float(w.w & 0xffff0000u);
}

__host__ __device__ __forceinline__ int in_colmap(int n) {
    if (n < 1280) { if ((n >= 768 && n < 896) || (n >= 1024 && n < 1152)) { const int w = n & 63; return (n & ~63) + (w >> 1) + 32 * (w & 1); } return n; }
    if (n < 5888) return n + 24;
    if (n < 5912) return 1280 + (n - 5888);
    return -1;
}
__device__ const double ROPE_INVF[32] = {1.0, 0.7498942093324559, 0.5623413251903491, 0.4216965034285822, 0.31622776601683794, 0.23713737056616552, 0.1778279410038923, 0.1333521432163324, 0.1, 0.07498942093324558, 0.05623413251903491, 0.042169650342858224, 0.03162277660168379, 0.023713737056616554, 0.01778279410038923, 0.01333521432163324, 0.01, 0.007498942093324558, 0.005623413251903491, 0.004216965034285823, 0.0031622776601683794, 0.0023713737056616554, 0.0017782794100389228, 0.001333521432163324, 0.001, 0.0007498942093324559, 0.0005623413251903491, 0.00042169650342858224, 0.00031622776601683794, 0.00023713737056616554, 0.00017782794100389227, 0.0001333521432163324};

using pg8::Unit;
struct EpiIn {
    static constexpr bool PERM = true, AFTER_DRAIN = false;
    unsigned char* ws; unsigned char* ob;
    template <int ACT> __device__ __forceinline__ void rows(const f32x4 (&acc)[2][2][4][2], const f32x4 (&bv)[2][2], bf16_t* dst, int ld, int row0) const {
#pragma unroll
        for (int ai = 0; ai < 2; ++ai)
#pragma unroll
            for (int m = 0; m < 4; ++m) { bf16_t* rowp = dst + (size_t)(row0 + ai * 128 + m * 16) * ld;
#pragma unroll
                for (int bj = 0; bj < 2; ++bj) { f32x4 v0 = acc[ai][bj][m][0] + bv[bj][0], v1 = acc[ai][bj][m][1] + bv[bj][1];
                    if (ACT == 1) { for (int i = 0; i < 4; ++i) { v0[i] = siluf_(v0[i]); v1[i] = siluf_(v1[i]); } }
                    if (ACT == 2) { for (int i = 0; i < 4; ++i) { v0[i] = sigmoidf_(v0[i]); v1[i] = sigmoidf_(v1[i]); } }
                    u32x4 w; w.x = pg8::cvt_pk_bf16(v0[0], v0[1]); w.y = pg8::cvt_pk_bf16(v0[2], v0[3]); w.z = pg8::cvt_pk_bf16(v1[0], v1[1]); w.w = pg8::cvt_pk_bf16(v1[2], v1[3]);
                    *(u32x4*)(rowp + bj * 128) = w; } }
    }
    __device__ __forceinline__ void operator()(const f32x4 (&acc)[2][2][4][2], const Unit& u, int wr, int wc, int fr, int fq) const {
        const int pn = u.pn, row0 = u.pm * 256 + wr * 64 + fr, cl0 = wc * 32 + 8 * fq;
        const float* biasp = (const float*)(ws + WS_MISC + MISC_BIASP) + pn * 256 + cl0;
        f32x4 bv[2][2];
#pragma unroll
        for (int bj = 0; bj < 2; ++bj)
#pragma unroll
            for (int n = 0; n < 2; ++n) bv[bj][n] = *(const f32x4*)(biasp + bj * 128 + 4 * n);
        if (pn < 2) { rows<0>(acc, bv, (bf16_t*)(ws + WS_QN) + pn * 256 + cl0, 512, row0); return; }
        if (pn < 5) {
            bf16_t* kb = (bf16_t*)(ws + WS_KV + (size_t)(2 * (pn - 2)) * KV_STRIDE); bf16_t* vb = (bf16_t*)(ws + WS_KV + (size_t)(2 * (pn - 2) + 1) * KV_STRIDE);
            const float* cosT = (const float*)(ws + WS_ROPE); const float* sinT = cosT + 4096 * 32;
            const int g = cl0 >> 6, w = cl0 & 63;
#pragma unroll
            for (int ai = 0; ai < 2; ++ai)
#pragma unroll
                for (int m = 0; m < 4; ++m) { const int r = row0 + ai * 128 + m * 16, b = r >> 12, t = r & 4095; const size_t ro = ((size_t)(b * 2 + g) * 4096 + t) * 64;
                    { f32x4 v0 = acc[ai][0][m][0] + bv[0][0], v1 = acc[ai][0][m][1] + bv[0][1];
                      if (pn > 2) { const int i0 = w >> 1; const f32x4 c = *(const f32x4*)(cosT + t * 32 + i0), s = *(const f32x4*)(sinT + t * 32 + i0);
                          const f32x4 x1 = {v0[0], v0[2], v1[0], v1[2]}, x2 = {v0[1], v0[3], v1[1], v1[3]};
                          const f32x4 lo = x1 * c - x2 * s, hi = x2 * c + x1 * s;
                          u32x2 a, bq; a.x = pg8::cvt_pk_bf16(lo[0], lo[1]); a.y = pg8::cvt_pk_bf16(lo[2], lo[3]); bq.x = pg8::cvt_pk_bf16(hi[0], hi[1]); bq.y = pg8::cvt_pk_bf16(hi[2], hi[3]);
                          *(u32x2*)(kb + ro + i0) = a; *(u32x2*)(kb + ro + 32 + i0) = bq;
                      } else { u32x4 wv; wv.x = pg8::cvt_pk_bf16(v0[0], v0[1]); wv.y = pg8::cvt_pk_bf16(v0[2], v0[3]); wv.z = pg8::cvt_pk_bf16(v1[0], v1[1]); wv.w = pg8::cvt_pk_bf16(v1[2], v1[3]); *(u32x4*)(kb + ro + w) = wv; } }
                    { const f32x4 v0 = acc[ai][1][m][0] + bv[1][0], v1 = acc[ai][1][m][1] + bv[1][1];
                      u32x4 wv; wv.x = pg8::cvt_pk_bf16(v0[0], v0[1]); wv.y = pg8::cvt_pk_bf16(v0[2], v0[3]); wv.z = pg8::cvt_pk_bf16(v1[0], v1[1]); wv.w = pg8::cvt_pk_bf16(v1[2], v1[3]); *(u32x4*)(vb + ro + w) = wv; } }
            return; }
        if (pn < 7)  { rows<1>(acc, bv, (bf16_t*)(ws + WS_ZA) + (pn - 5) * 256 + cl0, 512, row0); return; }
        if (pn < 9)  { rows<1>(acc, bv, (bf16_t*)(ob + OUT_QF) + (pn - 7) * 256 + cl0, 512, row0); return; }
        if (pn < 11) { rows<0>(acc, bv, (bf16_t*)(ob + OUT_FB) + (pn - 9) * 256 + cl0, 512, row0); return; }
        if (pn < 13) { rows<0>(acc, bv, (bf16_t*)(ob + OUT_IB) + (pn - 11) * 256 + cl0, 512, row0); return; }
        if (pn < 15) { rows<1>(acc, bv, (bf16_t*)(ws + WS_ZB) + (pn - 13) * 256 + cl0, 512, row0); return; }
        if (pn < 19) { rows<2>(acc, bv, (bf16_t*)(ws + WS_GMA) + (pn - 15) * 256 + cl0, 1024, row0); return; }
        if (pn < 23) { rows<2>(acc, bv, (bf16_t*)(ws + WS_GMB) + (pn - 19) * 256 + cl0, 1024, row0); return; }
        if (cl0 < 24) {
            float* gt = (float*)(ws + WS_GATE);
#pragma unroll
            for (int ai = 0; ai < 2; ++ai)
#pragma unroll
                for (int m = 0; m < 4; ++m) { const int r = row0 + ai * 128 + m * 16; f32x4 v0 = acc[ai][0][m][0] + bv[0][0], v1 = acc[ai][0][m][1] + bv[0][1];
                    for (int i = 0; i < 4; ++i) { v0[i] = sigmoidf_(v0[i]); v1[i] = sigmoidf_(v1[i]); }
                    *(f32x4*)(gt + (size_t)r * 24 + cl0) = v0; *(f32x4*)(gt + (size_t)r * 24 + cl0 + 4) = v1; } }
    }
};
struct EpiYA {
    static constexpr bool PERM = true, AFTER_DRAIN = false;
    const bf16_t* gate; float* ya;
    __device__ __forceinline__ void operator()(const f32x4 (&acc)[2][2][4][2], const Unit& u, int wr, int wc, int fr, int fq) const {
        const int row0 = u.pm * 256 + wr * 64 + fr, col0 = u.pn * 256 + wc * 32 + 8 * fq;
#pragma unroll
        for (int ai = 0; ai < 2; ++ai)
#pragma unroll
            for (int m = 0; m < 4; ++m)
#pragma unroll
                for (int bj = 0; bj < 2; ++bj) { const size_t off = (size_t)(row0 + ai * 128 + m * 16) * 1024 + col0 + bj * 128;
                    float g[8]; unpack8(*(const u32x4*)(gate + off), g);
                    f32x4 o0 = acc[ai][bj][m][0], o1 = acc[ai][bj][m][1];
                    for (int i = 0; i < 4; ++i) { o0[i] *= g[i]; o1[i] *= g[4 + i]; }
                    *(f32x4*)(ya + off) = o0; *(f32x4*)(ya + off + 4) = o1; }
    }
};
struct EpiYB {
    static constexpr bool PERM = true, AFTER_DRAIN = false;
    const bf16_t* gate; const float* ya; bf16_t* y;
    __device__ __forceinline__ void operator()(const f32x4 (&acc)[2][2][4][2], const Unit& u, int wr, int wc, int fr, int fq) const {
        const int row0 = u.pm * 256 + wr * 64 + fr, col0 = u.pn * 256 + wc * 32 + 8 * fq;
#pragma unroll
        for (int ai = 0; ai < 2; ++ai)
#pragma unroll
            for (int m = 0; m < 4; ++m)
#pragma unroll
                for (int bj = 0; bj < 2; ++bj) { const size_t off = (size_t)(row0 + ai * 128 + m * 16) * 1024 + col0 + bj * 128;
                    float g[8]; unpack8(*(const u32x4*)(gate + off), g);
                    f32x4 o0 = *(const f32x4*)(ya + off), o1 = *(const f32x4*)(ya + off + 4);
                    for (int i = 0; i < 4; ++i) { o0[i] += g[i] * acc[ai][bj][m][0][i]; o1[i] += g[4 + i] * acc[ai][bj][m][1][i]; }
                    u32x4 w; w.x = pg8::cvt_pk_bf16(o0[0], o0[1]); w.y = pg8::cvt_pk_bf16(o0[2], o0[3]); w.z = pg8::cvt_pk_bf16(o1[0], o1[1]); w.w = pg8::cvt_pk_bf16(o1[2], o1[3]);
                    *(u32x4*)(y + off) = w; }
    }
};
struct EpiOut {
    static constexpr bool PERM = true, AFTER_DRAIN = false;
    const float* x; float* out; float alpha;
    __device__ __forceinline__ void operator()(const f32x4 (&acc)[2][2][4][2], const Unit& u, int wr, int wc, int fr, int fq) const {
        const int row0 = u.pm * 256 + wr * 64 + fr, col0 = u.pn * 256 + wc * 32 + 8 * fq;
#pragma unroll
        for (int ai = 0; ai < 2; ++ai)
#pragma unroll
            for (int m = 0; m < 4; ++m)
#pragma unroll
                for (int bj = 0; bj < 2; ++bj) { const size_t off = (size_t)(row0 + ai * 128 + m * 16) * 1024 + col0 + bj * 128;
                    const f32x4 x0 = *(const f32x4*)(x + off), x1 = *(const f32x4*)(x + off + 4);
                    *(f32x4*)(out + off) = x0 * alpha + acc[ai][bj][m][0]; *(f32x4*)(out + off + 4) = x1 * alpha + acc[ai][bj][m][1]; }
    }
};

template <class CMap> __device__ __forceinline__ void transpose_item(const float* W, int K, int ldw, int Nn, bf16_t* WT, LAS float* scr, int item, int lane, const CMap& cmap) {
    const int nblk = Nn / 32, kb = item / nblk, nb = item % nblk, k0 = 64 * kb, n0 = 32 * nb;
    const int oc = cmap(n0 + (lane & 31));
#pragma unroll 8
    for (int i = 0; i < 32; ++i) { const int kk = 2 * i + (lane >> 5); scr[kk * 33 + (lane & 31)] = oc >= 0 ? W[(size_t)(k0 + kk) * ldw + oc] : 0.f; }
    asm volatile("s_waitcnt lgkmcnt(0)" ::: "memory");
    const int c = lane & 7;
#pragma unroll
    for (int j = 0; j < 4; ++j) { const int n = (lane >> 3) + 8 * j; const LAS float* s = scr + (8 * c) * 33 + n;
        u32x4 o; o.x = pk2(s[0 * 33], s[1 * 33]); o.y = pk2(s[2 * 33], s[3 * 33]); o.z = pk2(s[4 * 33], s[5 * 33]); o.w = pk2(s[6 * 33], s[7 * 33]);
        *(u32x4*)(WT + (size_t)(n0 + n) * K + k0 + 8 * c) = o; }
    asm volatile("s_waitcnt lgkmcnt(0)" ::: "memory");
}
struct CMapIn { __device__ __forceinline__ int operator()(int n) const { return in_colmap(n); } };
struct CMapId { __device__ __forceinline__ int operator()(int n) const { return n; } };


typedef short bf16x8 __attribute__((ext_vector_type(8)));
typedef short s16x4 __attribute__((ext_vector_type(4)));
typedef float f32x16 __attribute__((ext_vector_type(16)));
#define MFMA32(a, b, c) __builtin_amdgcn_mfma_f32_32x32x16_bf16((a), (b), (c), 0, 0, 0)
__device__ __forceinline__ int crow(int r, int hi) { return (r & 3) + 8 * (r >> 2) + 4 * hi; }
__device__ __forceinline__ unsigned cvtpk(float lo, float hi) { return pg8::cvt_pk_bf16(lo, hi); }
__device__ __forceinline__ bf16x8 ld8(const LAS unsigned char* p) { return *(const LAS bf16x8*)p; }
__device__ __forceinline__ bf16x8 ld4x2(const LAS unsigned char* p0, const LAS unsigned char* p1) { const s16x4 a = *(const LAS s16x4*)p0, b = *(const LAS s16x4*)p1; return (bf16x8){a[0], a[1], a[2], a[3], b[0], b[1], b[2], b[3]}; }
__device__ __forceinline__ bf16x8 accfrag(const f32x16& p, int s) {
    u32x4 w;
    if (s == 0) { w.x = cvtpk(p[0], p[1]); w.y = cvtpk(p[2], p[3]); w.z = cvtpk(p[4], p[5]); w.w = cvtpk(p[6], p[7]); }
    else { w.x = cvtpk(p[8], p[9]); w.y = cvtpk(p[10], p[11]); w.z = cvtpk(p[12], p[13]); w.w = cvtpk(p[14], p[15]); }
    return __builtin_bit_cast(bf16x8, w);
}
#define BLOCK_SYNC() __syncthreads()

constexpr int H_PKD = 144, H_PQE = 272;
constexpr int HL_VT = 0, HL_KDT = 18432, HL_TOT = 36864, HL_QE = 40960, HL_KE = 58368, HL_SS = 75776, HL_OT = 76800, HL_END = 76800 + 64 * 132 * 4;
static_assert(HL_END <= 131072, "hgrn lds");

__device__ __forceinline__ void hgrn_gate(const bf16_t* FB, const float* LBp, int r0, int colbase, int seg, int cp, float (&pre)[2][8], float (&kk)[2][8], LAS unsigned char* lds) {
    const float lb0 = LBp[colbase + 2 * cp], lb1 = LBp[colbase + 2 * cp + 1];
    float a0 = 0.f, a1 = 0.f;
#pragma unroll
    for (int i = 0; i < 8; ++i) { const unsigned w = *(const unsigned*)(FB + (size_t)(r0 + seg * 8 + i) * 512 + colbase + 2 * cp);
        const float s0 = sigmoidf_(bf2f(w & 0xffffu)), s1 = sigmoidf_(__uint_as_float(w & 0xffff0000u));
        const float f0 = lb0 + (1.f - lb0) * s0, f1 = lb1 + (1.f - lb1) * s1;
        a0 += __logf(f0); a1 += __logf(f1); pre[0][i] = a0; pre[1][i] = a1; kk[0][i] = (1.f - lb0) * (1.f - s0); kk[1][i] = (1.f - lb1) * (1.f - s1); }
    LAS float* tot = (LAS float*)(lds + HL_TOT);
    tot[seg * 128 + 2 * cp] = a0; tot[seg * 128 + 2 * cp + 1] = a1;
}
__device__ __forceinline__ void hgrn_stage_vt(const bf16_t* IB, int r0, int colbase, int tid, LAS unsigned char* lds) {
    const int c = tid & 63, ch = tid >> 6;
#pragma unroll
    for (int q = 0; q < 2; ++q) { const u32x4 w = *(const u32x4*)(IB + (size_t)(r0 + c) * 512 + colbase + 8 * (ch + 8 * q));
        LAS unsigned short* d = (LAS unsigned short*)(lds + HL_VT + (size_t)(8 * (ch + 8 * q)) * H_PKD + 2 * c);
        d[0 * (H_PKD / 2)] = (unsigned short)(w.x & 0xffffu); d[1 * (H_PKD / 2)] = (unsigned short)(w.x >> 16); d[2 * (H_PKD / 2)] = (unsigned short)(w.y & 0xffffu); d[3 * (H_PKD / 2)] = (unsigned short)(w.y >> 16);
        d[4 * (H_PKD / 2)] = (unsigned short)(w.z & 0xffffu); d[5 * (H_PKD / 2)] = (unsigned short)(w.z >> 16); d[6 * (H_PKD / 2)] = (unsigned short)(w.w & 0xffffu); d[7 * (H_PKD / 2)] = (unsigned short)(w.w >> 16); }
}
__device__ __forceinline__ void hgrn_offsets(int seg, int cp, float (&off)[2], float (&last)[2], LAS unsigned char* lds) {
    const LAS float* tot = (const LAS float*)(lds + HL_TOT);
    off[0] = off[1] = 0.f; last[0] = last[1] = 0.f;
#pragma unroll
    for (int s = 0; s < 8; ++s) { const float t0 = tot[s * 128 + 2 * cp], t1 = tot[s * 128 + 2 * cp + 1]; if (s < seg) { off[0] += t0; off[1] += t1; } last[0] += t0; last[1] += t1; }
}
__device__ __forceinline__ void hgrn_h1_unit(int unit, unsigned char* ws, unsigned char* ob, LAS unsigned char* lds, int tid, int lane, int wave) {
    const int bh = unit >> 6, n = unit & 63, b = bh >> 2, h = bh & 3, r0 = b * SEQ + n * 64, colbase = h * 128;
    const bf16_t* FB = (const bf16_t*)(ob + OUT_FB); const bf16_t* IB = (const bf16_t*)(ob + OUT_IB); const float* LBp = (const float*)(ws + WS_MISC + MISC_LB);
    float pre[2][8], kk[2][8], off[2], last[2];
    hgrn_gate(FB, LBp, r0, colbase, wave, lane, pre, kk, lds);
    hgrn_stage_vt(IB, r0, colbase, tid, lds);
    BLOCK_SYNC();
    hgrn_offsets(wave, lane, off, last, lds);
#pragma unroll
    for (int e = 0; e < 2; ++e) { float v[8];
#pragma unroll
        for (int i = 0; i < 8; ++i) v[i] = kk[e][i] * __expf(last[e] - (off[e] + pre[e][i]));
        u32x4 w; w.x = cvtpk(v[0], v[1]); w.y = cvtpk(v[2], v[3]); w.z = cvtpk(v[4], v[5]); w.w = cvtpk(v[6], v[7]);
        *(LAS u32x4*)(lds + HL_KDT + (size_t)(2 * lane + e) * H_PKD + 16 * wave) = w; }
    if (wave == 0) { float* dl = (float*)(ws + WS_DL) + (size_t)unit * 128 + 2 * lane; dl[0] = __expf(last[0]); dl[1] = __expf(last[1]); }
    BLOCK_SYNC();
    const int r = lane & 31, hh = lane >> 5, dvt = wave >> 1, dk0 = 2 * (wave & 1);
    f32x16 acc[2]; acc[0] = (f32x16){}; acc[1] = (f32x16){};
#pragma unroll
    for (int ks = 0; ks < 4; ++ks) { const bf16x8 a = ld8(lds + HL_VT + (size_t)(32 * dvt + r) * H_PKD + 32 * ks + 16 * hh);
#pragma unroll
        for (int t = 0; t < 2; ++t) { const bf16x8 bq = ld8(lds + HL_KDT + (size_t)(32 * (dk0 + t) + r) * H_PKD + 32 * ks + 16 * hh); acc[t] = MFMA32(a, bq, acc[t]); } }
    bf16_t* US = (bf16_t*)(ws + WS_XB) + (size_t)unit * 16384;
#pragma unroll
    for (int t = 0; t < 2; ++t)
#pragma unroll
        for (int g = 0; g < 16; ++g) US[(size_t)(32 * dvt + crow(g, hh)) * 128 + 32 * (dk0 + t) + r] = (bf16_t)f2bf(acc[t][g]);
    BLOCK_SYNC();
}
__device__ __forceinline__ void hgrn_h2(unsigned char* ws, int gtid, int ngt) {
    for (int e = gtid; e < 32 * 4096; e += ngt) { const int bh = e >> 12, q4 = e & 4095;
        bf16_t* us = (bf16_t*)(ws + WS_XB) + (size_t)bh * 64 * 16384 + 4 * q4; const float* dl = (const float*)(ws + WS_DL) + (size_t)bh * 64 * 128 + ((4 * q4) & 127);
        f32x4 st = {0.f, 0.f, 0.f, 0.f};
        for (int nb = 0; nb < 64; nb += 8) { u32x2 u[8]; f32x4 d[8];
#pragma unroll
            for (int i = 0; i < 8; ++i) { u[i] = *(const u32x2*)(us + (size_t)(nb + i) * 16384); d[i] = *(const f32x4*)(dl + (size_t)(nb + i) * 128); }
#pragma unroll
            for (int i = 0; i < 8; ++i) { u32x2 o; o.x = cvtpk(st[0], st[1]); o.y = cvtpk(st[2], st[3]); *(u32x2*)(us + (size_t)(nb + i) * 16384) = o;
                st[0] = d[i][0] * st[0] + bf2f(u[i].x & 0xffffu); st[1] = d[i][1] * st[1] + __uint_as_float(u[i].x & 0xffff0000u);
                st[2] = d[i][2] * st[2] + bf2f(u[i].y & 0xffffu); st[3] = d[i][3] * st[3] + __uint_as_float(u[i].y & 0xffff0000u); } } }
}
__device__ __forceinline__ void hgrn_h3_unit(int unit, unsigned char* ws, unsigned char* ob, const float* gnorm, LAS unsigned char* lds, int tid, int lane, int wave) {
    const int bh = unit >> 6, n = unit & 63, b = bh >> 2, h = bh & 3, r0 = b * SEQ + n * 64, colbase = h * 128;
    const bf16_t* FB = (const bf16_t*)(ob + OUT_FB); const bf16_t* IB = (const bf16_t*)(ob + OUT_IB); const bf16_t* QF = (const bf16_t*)(ob + OUT_QF); const float* LBp = (const float*)(ws + WS_MISC + MISC_LB);
    float pre[2][8], kk[2][8], off[2], last[2];
    hgrn_gate(FB, LBp, r0, colbase, wave, lane, pre, kk, lds);
    hgrn_stage_vt(IB, r0, colbase, tid, lds);
    unsigned qw[8];
#pragma unroll
    for (int i = 0; i < 8; ++i) qw[i] = *(const unsigned*)(QF + (size_t)(r0 + wave * 8 + i) * 512 + colbase + 2 * lane);
    BLOCK_SYNC();
    hgrn_offsets(wave, lane, off, last, lds);
#pragma unroll
    for (int i = 0; i < 8; ++i) { const float b0 = off[0] + pre[0][i], b1 = off[1] + pre[1][i];
        const float q0 = bf2f(qw[i] & 0xffffu) * __expf(b0), q1 = __uint_as_float(qw[i] & 0xffff0000u) * __expf(b1);
        const float k0 = kk[0][i] * __expf(-b0), k1 = kk[1][i] * __expf(-b1);
        *(LAS unsigned*)(lds + HL_QE + (size_t)(wave * 8 + i) * H_PQE + 4 * lane) = cvtpk(q0, q1);
        *(LAS unsigned*)(lds + HL_KE + (size_t)(wave * 8 + i) * H_PQE + 4 * lane) = cvtpk(k0, k1); }
    BLOCK_SYNC();
    const int r = lane & 31, hh = lane >> 5, dvt = wave >> 1, ct = wave & 1;
    f32x16 pt[2]; pt[0] = (f32x16){}; pt[1] = (f32x16){};
    f32x16 o = (f32x16){};
    const bf16_t* ST = (const bf16_t*)(ws + WS_XB) + (size_t)unit * 16384 + (size_t)(32 * dvt + r) * 128 + 8 * hh;
#pragma unroll
    for (int ks = 0; ks < 8; ++ks) { const bf16x8 bq = ld8(lds + HL_QE + (size_t)(32 * ct + r) * H_PQE + 32 * ks + 16 * hh);
        const bf16x8 a0 = ld8(lds + HL_KE + (size_t)r * H_PQE + 32 * ks + 16 * hh); pt[0] = MFMA32(a0, bq, pt[0]);
        if (ct == 1) { const bf16x8 a1 = ld8(lds + HL_KE + (size_t)(32 + r) * H_PQE + 32 * ks + 16 * hh); pt[1] = MFMA32(a1, bq, pt[1]); }
        const bf16x8 as = *(const bf16x8*)(ST + 16 * ks); o = MFMA32(as, bq, o); }
#pragma unroll
    for (int g = 0; g < 16; ++g) { if (crow(g, hh) > r) { if (ct == 0) pt[0][g] = 0.f; else pt[1][g] = 0.f; } }
#pragma unroll
    for (int st = 0; st < 2; ++st) { if (st <= ct) {
#pragma unroll
            for (int s2 = 0; s2 < 2; ++s2) { const LAS unsigned char* vp = lds + HL_VT + (size_t)(32 * dvt + r) * H_PKD + 2 * (32 * st + 16 * s2 + 4 * hh);
                const bf16x8 a = ld4x2(vp, vp + 16); o = MFMA32(a, accfrag(pt[st], s2), o); } } }
    float ss = 0.f;
#pragma unroll
    for (int g = 0; g < 16; ++g) ss += o[g] * o[g];
    ss += __shfl_xor(ss, 32);
    LAS float* SS = (LAS float*)(lds + HL_SS);
    if (hh == 0) SS[dvt * 64 + 32 * ct + r] = ss;
    BLOCK_SYNC();
    const float tot = SS[32 * ct + r] + SS[64 + 32 * ct + r] + SS[128 + 32 * ct + r] + SS[192 + 32 * ct + r];
    const float rstd = 1.0f / sqrtf(tot * (1.f / 128.f) + LN_EPS);
    LAS float* OT = (LAS float*)(lds + HL_OT);
#pragma unroll
    for (int g = 0; g < 16; ++g) { const int dv = 32 * dvt + crow(g, hh); OT[(32 * ct + r) * 132 + dv] = o[g] * rstd * gnorm[colbase + dv]; }
    BLOCK_SYNC();
    { const int c = tid >> 3, ch = tid & 7; const LAS float* src = OT + c * 132 + 16 * ch;
      const bf16_t* zb = (const bf16_t*)(ws + WS_ZB) + (size_t)(r0 + c) * 512 + colbase + 16 * ch; bf16_t* dst = (bf16_t*)(ws + WS_OB) + (size_t)(r0 + c) * 512 + colbase + 16 * ch;
#pragma unroll
      for (int q = 0; q < 2; ++q) { float z[8]; unpack8(*(const u32x4*)(zb + 8 * q), z); const f32x4 x0 = *(const LAS f32x4*)(src + 8 * q), x1 = *(const LAS f32x4*)(src + 8 * q + 4);
          u32x4 w; w.x = cvtpk(x0[0] * z[0], x0[1] * z[1]); w.y = cvtpk(x0[2] * z[2], x0[3] * z[3]); w.z = cvtpk(x1[0] * z[4], x1[1] * z[5]); w.w = cvtpk(x1[2] * z[6], x1[3] * z[7]); *(u32x4*)(dst + 8 * q) = w; } }
    BLOCK_SYNC();
}


constexpr int N_P = 144;
constexpr int NL_K = 0, NL_V = 18432, NL_IMPA = 36864, NL_IMPB = 53248, NL_SEL = 69632, NL_OT = 70144, NL_END = 70144 + 8 * 32 * 65 * 4;
static_assert(NL_END <= LDS_BYTES, "nsa lds");
constexpr float NSA_C2 = 0.125f * 1.4426950408889634f;
struct NsaStage { u32x4 k, v; };
__device__ __forceinline__ void nsa_load(NsaStage& s, const bf16_t* Kb, const bf16_t* Vb, int tile, int tid) {
    s.k = *(const u32x4*)(Kb + (size_t)(tile * 64 + (tid >> 3)) * 64 + 8 * (tid & 7));
    s.v = *(const u32x4*)(Vb + (size_t)(tile * 64 + (tid & 63)) * 64 + 8 * (tid >> 6));
}
__device__ __forceinline__ void nsa_store(const NsaStage& s, LAS unsigned char* lds, int buf, int tid) {
    *(LAS u32x4*)(lds + NL_K + buf * 9216 + (tid >> 3) * N_P + 16 * (tid & 7)) = s.k;
    LAS unsigned short* d = (LAS unsigned short*)(lds + NL_V + buf * 9216 + (8 * (tid >> 6)) * N_P + 2 * (tid & 63));
    d[0 * (N_P / 2)] = (unsigned short)(s.v.x & 0xffffu); d[1 * (N_P / 2)] = (unsigned short)(s.v.x >> 16); d[2 * (N_P / 2)] = (unsigned short)(s.v.y & 0xffffu); d[3 * (N_P / 2)] = (unsigned short)(s.v.y >> 16);
    d[4 * (N_P / 2)] = (unsigned short)(s.v.z & 0xffffu); d[5 * (N_P / 2)] = (unsigned short)(s.v.z >> 16); d[6 * (N_P / 2)] = (unsigned short)(s.v.w & 0xffffu); d[7 * (N_P / 2)] = (unsigned short)(s.v.w >> 16);
}
__device__ __forceinline__ void nsa_scores(f32x16& p0, f32x16& p1, const LAS unsigned char* kb, const bf16x8 (&qf)[4], int r32, int hi) {
    p0 = (f32x16){}; p1 = (f32x16){};
#pragma unroll
    for (int s = 0; s < 4; ++s) { const bf16x8 a0 = ld8(kb + r32 * N_P + 32 * s + 16 * hi), a1 = ld8(kb + (32 + r32) * N_P + 32 * s + 16 * hi); p0 = MFMA32(a0, qf[s], p0); p1 = MFMA32(a1, qf[s], p1); }
}
__device__ __forceinline__ void nsa_pv(f32x16 (&o)[2], const f32x16& p0, const f32x16& p1, const LAS unsigned char* vb, int r32, int hi) {
#pragma unroll
    for (int kh = 0; kh < 2; ++kh)
#pragma unroll
        for (int s2 = 0; s2 < 2; ++s2) { const bf16x8 bf = accfrag(kh ? p1 : p0, s2);
#pragma unroll
            for (int dt = 0; dt < 2; ++dt) { const LAS unsigned char* vp = vb + (32 * dt + r32) * N_P + 2 * (32 * kh + 16 * s2 + 4 * hi); o[dt] = MFMA32(ld4x2(vp, vp + 16), bf, o[dt]); } }
}
__device__ __forceinline__ void nsa_softmax_step(f32x16& p0, f32x16& p1, float& m, float& l, f32x16 (&o)[2]) {
    float mx = p0[0];
#pragma unroll
    for (int g = 1; g < 16; ++g) mx = fmaxf(mx, p0[g]);
#pragma unroll
    for (int g = 0; g < 16; ++g) mx = fmaxf(mx, p1[g]);
    mx = fmaxf(mx, __shfl_xor(mx, 32));
    const float mn = fmaxf(m, mx), al = __builtin_amdgcn_exp2f(m - mn);
    float rs = 0.f;
#pragma unroll
    for (int g = 0; g < 16; ++g) { p0[g] = __builtin_amdgcn_exp2f(p0[g] - mn); p1[g] = __builtin_amdgcn_exp2f(p1[g] - mn); rs += p0[g] + p1[g]; }
    rs += __shfl_xor(rs, 32);
    l = l * al + rs; m = mn;
#pragma unroll
    for (int g = 0; g < 16; ++g) { o[0][g] *= al; o[1][g] *= al; }
}
#define NSA_LOOP_BEGIN(Kb, Vb, T0, NT) { NsaStage sg_; nsa_load(sg_, (Kb), (Vb), (T0), tid); nsa_store(sg_, lds, 0, tid); BLOCK_SYNC(); \
    for (int it_ = 0; it_ < (NT); ++it_) { const int tile = (T0) + it_, buf_ = it_ & 1; if (it_ + 1 < (NT)) nsa_load(sg_, (Kb), (Vb), tile + 1, tid); \
        const LAS unsigned char* kb_ = lds + NL_K + buf_ * 9216; const LAS unsigned char* vb_ = lds + NL_V + buf_ * 9216; (void)kb_; (void)vb_;
#define NSA_LOOP_END(NT) if (it_ + 1 < (NT)) nsa_store(sg_, lds, buf_ ^ 1, tid); BLOCK_SYNC(); } }

__device__ __forceinline__ void nsa_unit(int bg, int qt, unsigned char* ws, LAS unsigned char* lds, int tid, int lane, int wave) {
    const int b = bg >> 1, g = bg & 1, r32 = lane & 31, hi = lane >> 5, tl = r32 & 7, head = r32 >> 3, tok0 = qt * 64, tw = 8 * wave + tl, t = tok0 + tw, r = b * SEQ + t, hg = g * 4 + head;
    const bf16_t* KC = (const bf16_t*)(ws + WS_KCC) + (size_t)bg * 256 * 64; const bf16_t* VC = (const bf16_t*)(ws + WS_KCC + MiB / 2) + (size_t)bg * 256 * 64;
    const bf16_t* KS = (const bf16_t*)(ws + WS_KV + 2 * KV_STRIDE) + (size_t)bg * 4096 * 64; const bf16_t* VS = (const bf16_t*)(ws + WS_KV + 3 * KV_STRIDE) + (size_t)bg * 4096 * 64;
    const bf16_t* KW = (const bf16_t*)(ws + WS_KV + 4 * KV_STRIDE) + (size_t)bg * 4096 * 64; const bf16_t* VW = (const bf16_t*)(ws + WS_KV + 5 * KV_STRIDE) + (size_t)bg * 4096 * 64;
    bf16x8 qf[4];
#pragma unroll
    for (int s = 0; s < 4; ++s) qf[s] = *(const bf16x8*)((const bf16_t*)(ws + WS_QN) + (size_t)r * 512 + hg * 64 + 16 * s + 8 * hi);
    const float* gp = (const float*)(ws + WS_GATE) + (size_t)r * 24 + hg * 3;
    const float g0 = gp[0], g1 = gp[1], g2 = gp[2];
    LAS float* OT = (LAS float*)(lds + NL_OT) + wave * 32 * 65 + r32 * 65;
    f32x16 o[2], p0, p1;
    const int nv = t >= 31 ? ((t - 31) / 16 + 1 > 255 ? 255 : (t - 31) / 16 + 1) : 0;
    const int tlast = tok0 + 63, nvmax = tlast >= 31 ? ((tlast - 31) / 16 + 1 > 255 ? 255 : (tlast - 31) / 16 + 1) : 0, ntc = (nvmax + 63) >> 6;
    float m = -1e30f, l = 0.f;
    if (ntc > 0) {
        NSA_LOOP_BEGIN(KC, VC, 0, ntc)
            nsa_scores(p0, p1, kb_, qf, r32, hi);
            float mx = -INFINITY;
#pragma unroll
            for (int gq = 0; gq < 16; ++gq) { const int n0 = tile * 64 + crow(gq, hi); p0[gq] = n0 < nv ? p0[gq] * NSA_C2 : -INFINITY; p1[gq] = n0 + 32 < nv ? p1[gq] * NSA_C2 : -INFINITY; mx = fmaxf(mx, fmaxf(p0[gq], p1[gq])); }
            mx = fmaxf(mx, __shfl_xor(mx, 32));
            const float mn = fmaxf(m, mx); float rs = 0.f;
#pragma unroll
            for (int gq = 0; gq < 16; ++gq) rs += __builtin_amdgcn_exp2f(p0[gq] - mn) + __builtin_amdgcn_exp2f(p1[gq] - mn);
            rs += __shfl_xor(rs, 32);
            l = l * __builtin_amdgcn_exp2f(m - mn) + rs; m = mn;
        NSA_LOOP_END(ntc)
        const float rl = l > 0.f ? 1.f / l : 0.f;
        o[0] = (f32x16){}; o[1] = (f32x16){};
        LAS float* impA = (LAS float*)(lds + NL_IMPA) + (8 * wave + tl) * 64; LAS float* impB = (LAS float*)(lds + NL_IMPB) + (8 * wave + tl) * 64;
        NSA_LOOP_BEGIN(KC, VC, 0, ntc)
            nsa_scores(p0, p1, kb_, qf, r32, hi);
#pragma unroll
            for (int gq = 0; gq < 16; ++gq) { const int n0 = tile * 64 + crow(gq, hi); p0[gq] = n0 < nv ? __builtin_amdgcn_exp2f(p0[gq] * NSA_C2 - m) * rl : 0.f; p1[gq] = n0 + 32 < nv ? __builtin_amdgcn_exp2f(p1[gq] * NSA_C2 - m) * rl : 0.f; }
#pragma unroll
            for (int rq = 0; rq < 4; ++rq) {
                float qa = (p0[4 * rq] + p0[4 * rq + 1]) + (p0[4 * rq + 2] + p0[4 * rq + 3]), la = p0[4 * rq + 3];
                float qb = (p1[4 * rq] + p1[4 * rq + 1]) + (p1[4 * rq + 2] + p1[4 * rq + 3]), lb = p1[4 * rq + 3];
                qa += __shfl_xor(qa, 8); qa += __shfl_xor(qa, 16); la += __shfl_xor(la, 8); la += __shfl_xor(la, 16);
                qb += __shfl_xor(qb, 8); qb += __shfl_xor(qb, 16); lb += __shfl_xor(lb, 8); lb += __shfl_xor(lb, 16);
                if (head == 0) { const int j0 = tile * 16 + 2 * rq + hi; impA[j0] = qa; impA[j0 + 8] = qb; impB[j0 + 1] = la; if (j0 + 9 < 64) impB[j0 + 9] = lb; } }
            nsa_pv(o, p0, p1, vb_, r32, hi);
        NSA_LOOP_END(ntc)
#pragma unroll
        for (int gq = 0; gq < 16; ++gq) { OT[crow(gq, hi)] = g0 * o[0][gq]; OT[32 + crow(gq, hi)] = g0 * o[1][gq]; }
    } else {
#pragma unroll
        for (int gq = 0; gq < 16; ++gq) { OT[crow(gq, hi)] = 0.f; OT[32 + crow(gq, hi)] = 0.f; }
    }
    const int cur = qt;
    {
        for (int tt = 0; tt < 8; ++tt) { const int tk = 8 * wave + tt;
            const LAS float* iA = (const LAS float*)(lds + NL_IMPA) + tk * 64; const LAS float* iB = (const LAS float*)(lds + NL_IMPB) + tk * 64;
            float v = -INFINITY;
            if (lane <= cur) v = (lane == 0 || lane == cur || lane == cur - 1) ? 1e30f : iA[lane] + iB[lane];
            int rank = 0;
            for (int i = 0; i < 64; ++i) { const float vi = __uint_as_float(__builtin_amdgcn_readlane(__float_as_uint(v), i)); rank += (vi > v || (vi == v && i < lane)) ? 1 : 0; }
            const unsigned long long mk = __ballot(rank < 16 && v > -INFINITY);
            if (lane == 0) *(LAS unsigned long long*)(lds + NL_SEL + tk * 8) = mk; }
    }
    const unsigned long long selm = *(const LAS unsigned long long*)(lds + NL_SEL + (8 * wave + tl) * 8);
    { const float* cosT = (const float*)(ws + WS_ROPE) + t * 32; const float* sinT = cosT + 4096 * 32;
#pragma unroll
      for (int s = 0; s < 2; ++s) {
          const f32x4 ca = *(const f32x4*)(cosT + 16 * s + 8 * hi), cb = *(const f32x4*)(cosT + 16 * s + 8 * hi + 4), sa = *(const f32x4*)(sinT + 16 * s + 8 * hi), sb = *(const f32x4*)(sinT + 16 * s + 8 * hi + 4);
          float x1[8], x2[8]; unpack8(__builtin_bit_cast(u32x4, qf[s]), x1); unpack8(__builtin_bit_cast(u32x4, qf[s + 2]), x2);
          u32x4 a, bq;
          a.x = cvtpk(x1[0] * ca[0] - x2[0] * sa[0], x1[1] * ca[1] - x2[1] * sa[1]); a.y = cvtpk(x1[2] * ca[2] - x2[2] * sa[2], x1[3] * ca[3] - x2[3] * sa[3]);
          a.z = cvtpk(x1[4] * cb[0] - x2[4] * sb[0], x1[5] * cb[1] - x2[5] * sb[1]); a.w = cvtpk(x1[6] * cb[2] - x2[6] * sb[2], x1[7] * cb[3] - x2[7] * sb[3]);
          bq.x = cvtpk(x2[0] * ca[0] + x1[0] * sa[0], x2[1] * ca[1] + x1[1] * sa[1]); bq.y = cvtpk(x2[2] * ca[2] + x1[2] * sa[2], x2[3] * ca[3] + x1[3] * sa[3]);
          bq.z = cvtpk(x2[4] * cb[0] + x1[4] * sb[0], x2[5] * cb[1] + x1[5] * sb[1]); bq.w = cvtpk(x2[6] * cb[2] + x1[6] * sb[2], x2[7] * cb[3] + x1[7] * sb[3]);
          qf[s] = __builtin_bit_cast(bf16x8, a); qf[s + 2] = __builtin_bit_cast(bf16x8, bq); } }
    { m = -1e30f; l = 0.f; o[0] = (f32x16){}; o[1] = (f32x16){};
      NSA_LOOP_BEGIN(KS, VS, 0, cur + 1)
          const bool sel = (selm >> tile) & 1ull;
          if (__any(sel)) {
              nsa_scores(p0, p1, kb_, qf, r32, hi);
#pragma unroll
              for (int gq = 0; gq < 16; ++gq) { const int k0 = crow(gq, hi); const bool ok0 = sel && (tile < cur || k0 <= tw), ok1 = sel && (tile < cur || k0 + 32 <= tw);
                  p0[gq] = ok0 ? p0[gq] * NSA_C2 : -INFINITY; p1[gq] = ok1 ? p1[gq] * NSA_C2 : -INFINITY; }
              nsa_softmax_step(p0, p1, m, l, o);
              nsa_pv(o, p0, p1, vb_, r32, hi); }
      NSA_LOOP_END(cur + 1)
      const float sc = l > 0.f ? g1 / l : 0.f;
#pragma unroll
      for (int gq = 0; gq < 16; ++gq) { OT[crow(gq, hi)] += sc * o[0][gq]; OT[32 + crow(gq, hi)] += sc * o[1][gq]; } }
    { m = -1e30f; l = 0.f; o[0] = (f32x16){}; o[1] = (f32x16){};
      const int jlo = cur >= 8 ? cur - 8 : 0, ntw = cur - jlo + 1;
      NSA_LOOP_BEGIN(KW, VW, jlo, ntw)
          nsa_scores(p0, p1, kb_, qf, r32, hi);
          const bool first = (tile == cur - 8), lastt = (tile == cur);
#pragma unroll
          for (int gq = 0; gq < 16; ++gq) { const int k0 = crow(gq, hi);
              const bool ok0 = (!first || k0 > tw) && (!lastt || k0 <= tw), ok1 = (!first || k0 + 32 > tw) && (!lastt || k0 + 32 <= tw);
              p0[gq] = ok0 ? p0[gq] * NSA_C2 : -INFINITY; p1[gq] = ok1 ? p1[gq] * NSA_C2 : -INFINITY; }
          nsa_softmax_step(p0, p1, m, l, o);
          nsa_pv(o, p0, p1, vb_, r32, hi);
      NSA_LOOP_END(ntw)
      const float sc = l > 0.f ? g2 / l : 0.f;
#pragma unroll
      for (int gq = 0; gq < 16; ++gq) { OT[crow(gq, hi)] += sc * o[0][gq]; OT[32 + crow(gq, hi)] += sc * o[1][gq]; } }
    { const LAS float* OTw = (const LAS float*)(lds + NL_OT) + wave * 32 * 65;
      asm volatile("s_waitcnt lgkmcnt(0)" ::: "memory");
#pragma unroll
      for (int i = 0; i < 4; ++i) { const int item = lane + 64 * i, q = item >> 3, ch = item & 7; const LAS float* src = OTw + q * 65 + 8 * ch;
          const int rr = b * SEQ + tok0 + 8 * wave + (q & 7), col = (g * 4 + (q >> 3)) * 64 + 8 * ch;
          float z[8]; unpack8(*(const u32x4*)((const bf16_t*)(ws + WS_ZA) + (size_t)rr * 512 + col), z);
          u32x4 w; w.x = cvtpk(src[0] * z[0], src[1] * z[1]); w.y = cvtpk(src[2] * z[2], src[3] * z[3]); w.z = cvtpk(src[4] * z[4], src[5] * z[5]); w.w = cvtpk(src[6] * z[6], src[7] * z[7]);
          *(u32x4*)((bf16_t*)(ws + WS_OA) + (size_t)rr * 512 + col) = w; }
      asm volatile("s_waitcnt lgkmcnt(0)" ::: "memory"); }
    BLOCK_SYNC();
}


struct EpiF32 {
    static constexpr bool PERM = true, AFTER_DRAIN = false;
    float* out; int ld;
    __device__ __forceinline__ void operator()(const f32x4 (&acc)[2][2][4][2], const Unit& u, int wr, int wc, int fr, int fq) const {
        const int row0 = u.pm * 256 + wr * 64 + fr, col0 = u.pn * 256 + wc * 32 + 8 * fq;
#pragma unroll
        for (int ai = 0; ai < 2; ++ai)
#pragma unroll
            for (int m = 0; m < 4; ++m)
#pragma unroll
                for (int bj = 0; bj < 2; ++bj) { const size_t off = (size_t)(row0 + ai * 128 + m * 16) * ld + col0 + bj * 128; *(f32x4*)(out + off) = acc[ai][bj][m][0]; *(f32x4*)(out + off + 4) = acc[ai][bj][m][1]; }
    }
};
__device__ __forceinline__ void compress2(unsigned char* ws, const float* w2k, const float* w2v, LAS unsigned char* lds, int gw, int ngw, int lane, int wave) {
    LAS float* hb = (LAS float*)(lds + wave * 512);
    for (int row = gw; row < 8192; row += ngw) { const int kv = row >> 12, bg = (row >> 8) & 15, n = row & 255;
        bf16_t* dst = (bf16_t*)(ws + WS_KCC + (size_t)kv * (MiB / 2)) + ((size_t)bg * 256 + n) * 64 + lane;
        if (n == 255) { *dst = (bf16_t)0; continue; }
        const float* pp = (const float*)(ws + WS_PP + (size_t)kv * 4 * MiB) + (size_t)(bg * 256 + n) * 256; const float* c1 = (const float*)(ws + WS_MISC + MISC_C1) + kv * 128; const float* w2 = kv ? w2v : w2k;
        hb[lane] = siluf_(pp[lane] + pp[256 + 128 + lane] + c1[lane]); hb[64 + lane] = siluf_(pp[64 + lane] + pp[256 + 128 + 64 + lane] + c1[64 + lane]);
        asm volatile("s_waitcnt lgkmcnt(0)" ::: "memory");
        float o = 0.f;
#pragma unroll 8
        for (int j = 0; j < 128; ++j) o += hb[j] * w2[j * 64 + lane];
        *dst = (bf16_t)f2bf(o);
        asm volatile("s_waitcnt lgkmcnt(0)" ::: "memory"); }
}

struct Args { const float* in[16]; float* out; unsigned char* ws; int ph_lo, ph_hi; };
enum { I_X = 0, I_WIN, I_BIN, I_PEK, I_WK1, I_WK2, I_PEV, I_WV1, I_WV2, I_LB, I_HG, I_WA, I_WB, I_WO, I_LNG, I_LNB };

__global__ void __launch_bounds__(512, 2) mega(Args a) {
    extern __shared__ __attribute__((aligned(16))) unsigned char lds_raw[];
    LAS unsigned char* lds = (LAS unsigned char*)lds_raw;
    const int tid = threadIdx.x, lane = tid & 63, wave = __builtin_amdgcn_readfirstlane(tid >> 6);
    const int G = gridDim.x, bx = blockIdx.x;
    const int gw = bx * 8 + wave, NGW = G * 8;
    unsigned char* ws = a.ws; unsigned char* ob = (unsigned char*)a.out;
    const int lo = a.ph_lo, hi = a.ph_hi;
#define IN(k) (lo <= (k) && (k) < hi)
#define SEAM(k) do { if (IN(k) && IN((k) + 1)) { cg::this_grid().sync(); } } while (0)
    if (IN(0)) {
        LAS float* scr = (LAS float*)(lds + wave * 16384);
        constexpr int NI_IN = 16 * (NINP / 32), NI_A = 8 * 32, NI_O = 16 * 32, NI_C = 16 * 4, NITEMS = NI_IN + 2 * NI_A + NI_O + 4 * NI_C;
        for (int it = gw; it < NITEMS; it += NGW) {
            int r = it;
            if (r < NI_IN) { transpose_item(a.in[I_WIN], 1024, NIN, NINP, (bf16_t*)(ws + WS_WIN), scr, r, lane, CMapIn()); continue; } r -= NI_IN;
            if (r < NI_A) { transpose_item(a.in[I_WA], 512, 1024, 1024, (bf16_t*)(ws + WS_WA), scr, r, lane, CMapId()); continue; } r -= NI_A;
            if (r < NI_A) { transpose_item(a.in[I_WB], 512, 1024, 1024, (bf16_t*)(ws + WS_WB), scr, r, lane, CMapId()); continue; } r -= NI_A;
            if (r < NI_O) { transpose_item(a.in[I_WO], 1024, 1024, 1024, (bf16_t*)(ws + WS_WO), scr, r, lane, CMapId()); continue; } r -= NI_O;
            { const int q = r / NI_C, kv = q >> 1, half = q & 1;
              transpose_item(a.in[kv ? I_WV1 : I_WK1] + (size_t)half * 1024 * 128, 1024, 128, 128, (bf16_t*)(ws + WS_W1T + (size_t)kv * (MiB / 2)) + (size_t)half * 128 * 1024, scr, r % NI_C, lane, CMapId()); }
        }
        for (int oi = gw; oi < 256; oi += NGW) { const int kv = oi >> 7, j = oi & 127; const float* pe = a.in[kv ? I_PEV : I_PEK]; const float* w1 = a.in[kv ? I_WV1 : I_WK1];
            float s = 0.f; for (int i = lane; i < 2048; i += 64) s += pe[i] * w1[(size_t)i * 128 + j];
#pragma unroll
            for (int of = 1; of < 64; of <<= 1) s += __shfl_xor(s, of);
            if (lane == 0) ((float*)(ws + WS_MISC + MISC_C1))[oi] = s; }
        for (int m = gw; m < T; m += NGW) { const f32x4* xr = (const f32x4*)(a.in[I_X] + (size_t)m * DM) + lane; u32x2* o8 = (u32x2*)((bf16_t*)(ws + WS_XB) + (size_t)m * DM) + lane;
#pragma unroll
            for (int j = 0; j < 4; ++j) { const f32x4 v = xr[64 * j]; u32x2 o; o.x = pk2(v.x, v.y); o.y = pk2(v.z, v.w); o8[64 * j] = o; } }
        const int gt = bx * 512 + tid, NGT = G * 512;
        float* cosT = (float*)(ws + WS_ROPE); float* sinT = cosT + 4096 * 32;
        for (int i = gt; i < 4096 * 32; i += NGT) { const int pos = i >> 5, k = i & 31; const double rev = (double)pos * ROPE_INVF[k] * 0.15915494309189535; const float fr = (float)(rev - floor(rev));
            cosT[i] = __builtin_amdgcn_cosf(fr); sinT[i] = __builtin_amdgcn_sinf(fr); }
        for (int i = gt; i < NINP; i += NGT) { const int oc = in_colmap(i); ((float*)(ws + WS_MISC + MISC_BIASP))[i] = oc >= 0 ? a.in[I_BIN][oc] : 0.f; }
        for (int i = gt; i < 512; i += NGT) { const float l0 = a.in[I_LB][i], l1 = a.in[I_LB][512 + i]; ((float*)(ws + WS_MISC + MISC_LB))[i] = 1.0f / (1.0f + expf(l1 - l0)); }
    }
    SEAM(0);
    if (IN(1)) {
        pg8::Gemm g{(const bf16_t*)(ws + WS_XB), (const bf16_t*)(ws + WS_WIN), T, NINP, DM}; pg8::StaticOrder S; S.init(T, NINP, G, bx);
        EpiIn E{ws, ob};
        pg8::gemm_phase<EpiIn, pg8::StaticOrder, true, true>(lds, g, S, E);
    }
    SEAM(1);
    if (IN(2)) {
        if (bx < 32) { const int kv = bx >> 4;
            pg8::Gemm g{(const bf16_t*)(ws + WS_KV + (size_t)kv * KV_STRIDE), (const bf16_t*)(ws + WS_W1T + (size_t)kv * (MiB / 2)), 4096, 256, 1024}; pg8::StaticOrder S; S.init(4096, 256, 16, bx & 15);
            EpiF32 E{(float*)(ws + WS_PP + (size_t)kv * 4 * MiB), 256};
            pg8::gemm_phase<EpiF32, pg8::StaticOrder, false, true>(lds, g, S, E); __syncthreads(); }
        for (int u = bx; u < 2048; u += G) hgrn_h1_unit(u, ws, ob, lds, tid, lane, wave); }
    SEAM(2);
    if (IN(3)) { compress2(ws, a.in[I_WK2], a.in[I_WV2], lds, gw, NGW, lane, wave); hgrn_h2(ws, bx * 512 + tid, G * 512); }
    SEAM(3);
    if (IN(4)) {
        if (G == 256) { const int bg = bx >> 4, i0 = bx & 15;
            nsa_unit(bg, 63 - i0, ws, lds, tid, lane, wave); nsa_unit(bg, 32 + i0, ws, lds, tid, lane, wave); nsa_unit(bg, 31 - i0, ws, lds, tid, lane, wave); nsa_unit(bg, i0, ws, lds, tid, lane, wave); }
        else { for (int u = bx; u < 1024; u += G) nsa_unit(u >> 6, u & 63, ws, lds, tid, lane, wave); }
        for (int u = bx; u < 2048; u += G) hgrn_h3_unit(u, ws, ob, a.in[I_HG], lds, tid, lane, wave); }
    SEAM(4);
    if (IN(5)) {
        { pg8::Gemm g{(const bf16_t*)(ws + WS_OA), (const bf16_t*)(ws + WS_WA), T, DM, 512}; pg8::StaticOrder S; S.init(T, DM, G, bx);
          EpiYA E{(const bf16_t*)(ws + WS_GMA), a.out};
          pg8::gemm_phase<EpiYA, pg8::StaticOrder, true, true>(lds, g, S, E); }
        __syncthreads();
        { pg8::Gemm g{(const bf16_t*)(ws + WS_OB), (const bf16_t*)(ws + WS_WB), T, DM, 512}; pg8::StaticOrder S; S.init(T, DM, G, bx);
          EpiYB E{(const bf16_t*)(ws + WS_GMB), a.out, (bf16_t*)(ws + WS_Y)};
          pg8::gemm_phase<EpiYB, pg8::StaticOrder, true, true>(lds, g, S, E); }
    }
    SEAM(5);
    if (IN(6)) {
        pg8::Gemm g{(const bf16_t*)(ws + WS_Y), (const bf16_t*)(ws + WS_WO), T, DM, DM}; pg8::StaticOrder S; S.init(T, DM, G, bx);
        EpiOut E{a.in[I_X], a.out, 1.189207115002721f};
        pg8::gemm_phase<EpiOut, pg8::StaticOrder, true, true>(lds, g, S, E);
    }
    SEAM(6);
    if (IN(7)) {
        const f32x4* gp = (const f32x4*)a.in[I_LNG] + lane; const f32x4* bp = (const f32x4*)a.in[I_LNB] + lane;
        for (int m = gw; m < T; m += NGW) { f32x4* xr = (f32x4*)(a.out + (size_t)m * DM) + lane;
            f32x4 v[4]; float s = 0.f;
#pragma unroll
            for (int j = 0; j < 4; ++j) { v[j] = xr[64 * j]; s += (v[j].x + v[j].y) + (v[j].z + v[j].w); }
#pragma unroll
            for (int o = 1; o < 64; o <<= 1) s += __shfl_xor(s, o);
            const float mean = s * (1.f / DM); float s2 = 0.f;
#pragma unroll
            for (int j = 0; j < 4; ++j) { v[j] = v[j] - mean; s2 += (v[j].x * v[j].x + v[j].y * v[j].y) + (v[j].z * v[j].z + v[j].w * v[j].w); }
#pragma unroll
            for (int o = 1; o < 64; o <<= 1) s2 += __shfl_xor(s2, o);
            const float rstd = 1.f / sqrtf(s2 * (1.f / DM) + LN_EPS);
#pragma unroll
            for (int j = 0; j < 4; ++j) xr[64 * j] = v[j] * rstd * gp[64 * j] + bp[64 * j]; }
    }
#undef IN
#undef SEAM
}

extern "C" void kernel_launch(void* const* d_in, const int* in_sizes, int n_in, void* d_out, int out_size, void* d_ws, size_t ws_size, hipStream_t stream) {
    static int grid = 0;
    if (grid == 0) {
        if (n_in != 16 || in_sizes[0] != T * DM || out_size != T * DM || ws_size < WS_END) { fprintf(stderr, "kernel_launch: unexpected shapes (n_in %d, in0 %d, out %d, ws %zu)\n", n_in, n_in > 0 ? in_sizes[0] : -1, out_size, ws_size); grid = -1; return; }
        int dev = 0, cus = 0;
        if (hipGetDevice(&dev) != hipSuccess || hipDeviceGetAttribute(&cus, hipDeviceAttributeMultiprocessorCount, dev) != hipSuccess) { grid = -1; return; }
        if (hipFuncSetAttribute((const void*)mega, hipFuncAttributeMaxDynamicSharedMemorySize, LDS_BYTES) != hipSuccess) { fprintf(stderr, "kernel_launch: hipFuncSetAttribute failed\n"); grid = -1; return; }
        int per_cu = 0; if (hipOccupancyMaxActiveBlocksPerMultiprocessor(&per_cu, (const void*)mega, 512, LDS_BYTES) != hipSuccess || per_cu < 1) { fprintf(stderr, "kernel_launch: occupancy query says %d blocks per CU\n", per_cu); grid = -1; return; }
        grid = cus;
    }
    if (grid < 0) return;
    Args a{};
    for (int i = 0; i < 16; ++i) a.in[i] = (const float*)d_in[i];
    a.out = (float*)d_out; a.ws = (unsigned char*)d_ws;
    a.ph_lo = 0; a.ph_hi = 8;
    void* args[] = {&a};
    hipError_t e = hipLaunchCooperativeKernel((const void*)mega, dim3(grid), dim3(512), args, LDS_BYTES, stream);
    if (e != hipSuccess) fprintf(stderr, "kernel_launch: cooperative launch failed: %s (grid %d)\n", hipGetErrorString(e), grid);
}
```

```cpp
#include <hip/hip_runtime.h>
#include <hip/hip_cooperative_groups.h>
#include <cstdio>
#include <cstdint>
namespace cg = cooperative_groups;
namespace pg8 {
#define PG8_LAS __attribute__((address_space(3)))
typedef unsigned short bf16_t;
typedef short bf16x8 __attribute__((ext_vector_type(8)));
typedef float f32x4 __attribute__((ext_vector_type(4)));
typedef unsigned u32x4 __attribute__((ext_vector_type(4)));
constexpr int BM = 256, BK = 64, HALF = 128, HTB = HALF * BK * 2  , STAGE_BYTES = 8 * HTB, NXCD = 8, WGM = 8;

__host__ __device__ __forceinline__ int lds_byte(int r, int c) { const int st = (r >> 4) * 2 + (c >> 5), rr = r & 15, cc = c & 31, ob = rr * 64 + cc * 2; return st * 1024 + (ob ^ (((ob >> 9) & 1) << 5)); }
__host__ __device__ __forceinline__ void stage_rc(int b, int& R, int& C) { const int st = b / 1024, sb = b % 1024, swz = sb ^ (((sb >> 9) & 1) << 5); R = (st >> 1) * 16 + swz / 64; C = (st & 1) * 32 + (swz % 64) / 2; }
__host__ __device__ __forceinline__ int perm32(int rho) { const int n = rho >> 4, i = rho & 15; return 8 * (i >> 2) + 4 * n + (i & 3); }

struct Unit { int pm, pn; };
struct Gemm { const bf16_t* A; const bf16_t* Bt; int M, N, K; };

struct StaticOrder {
    int nM, nN, nwg, G, c;
    __host__ __device__ void init(int M, int N, int G_, int c_) { nM = M / BM; nN = N / BM; nwg = nM * nN; G = G_; c = c_; }
    __host__ __device__ bool next(int i, Unit& u) const {
        const long L = (long)i * G + c; if (L >= nwg) return false;
        int wgid = (int)L; { const int q = nwg / NXCD, r = nwg % NXCD, xcd = wgid % NXCD, off = wgid / NXCD; wgid = (xcd < r ? xcd * (q + 1) : r * (q + 1) + (xcd - r) * q) + off; }
        const int nig = WGM * nN, gid = wgid / nig, fm = gid * WGM, gsz = (nM - fm) < WGM ? (nM - fm) : WGM;
        u.pm = fm + ((wgid % nig) % gsz); u.pn = (wgid % nig) / gsz; return true;
    }
    __device__ __forceinline__ void a_ready(const Unit&) const {}
    __device__ __forceinline__ void done(const Unit&) const {}
};

typedef float f32x2_t_ __attribute__((ext_vector_type(2))); typedef __bf16 bf16x2_t_ __attribute__((ext_vector_type(2)));
__device__ __forceinline__ unsigned cvt_pk_bf16(float lo, float hi) { f32x2_t_ v = {lo, hi}; bf16x2_t_ b = __builtin_convertvector(v, bf16x2_t_); return __builtin_bit_cast(unsigned, b); }
typedef float f32x2 __attribute__((ext_vector_type(2)));
template <class Epi, class Sched, bool ALIGN_EPI = false, bool SP2 = false>
__device__ __forceinline__ void gemm_phase(PG8_LAS unsigned char* lds, const Gemm g, const Sched& S, const Epi& E) {
    const int tid = threadIdx.x, wid = __builtin_amdgcn_readfirstlane(tid >> 6), lane = tid & 63, wr = wid >> 2, wc = wid & 3, fr = lane & 15, fq = lane >> 4;
    const int K = g.K, nt = K / BK;
    unsigned voffA[2], voffB[2];
#pragma unroll
    for (int i = 0; i < 2; ++i) { int R, C; stage_rc(tid * 16 + i * 8192, R, C); const int Rb = Epi::PERM ? ((R & ~31) + perm32(R & 31)) : R;
        voffA[i] = (unsigned)(R * K + C) * 2u; voffB[i] = (unsigned)(Rb * K + C) * 2u; }
    const size_t kstep = (size_t)(BK * 2);
    const size_t hstep = (size_t)HALF * K * 2;
    const size_t tstep = 2 * hstep;
    const unsigned ldsw = (unsigned)wid * 1024u;
    const int aoff = lds_byte(wr * 64 + fr, fq * 8), boff = lds_byte(wc * 32 + fr, fq * 8);
#define PG8_SA(b, h) (((b) * 2 + (h)) * HTB)
#define PG8_SB(b, h) ((4 + (b) * 2 + (h)) * HTB)
#define PG8_STAGE(bufoff, gbase, voff) do { _Pragma("unroll") for (int _i = 0; _i < 2; ++_i) \
        __builtin_amdgcn_global_load_lds((const unsigned*)((const char*)(gbase) + (voff)[_i]), (PG8_LAS unsigned*)(lds + (bufoff) + ldsw + _i * 8192), 16, 0, 0); } while (0)
#define PG8_LDA(dst, b, h) do { _Pragma("unroll") for (int m = 0; m < 4; ++m) _Pragma("unroll") for (int k = 0; k < 2; ++k) dst[m][k] = *(const PG8_LAS bf16x8*)(lds + PG8_SA(b, h) + aoff + m * 2048 + k * 1024); } while (0)
#define PG8_LDB(dst, b, h) do { _Pragma("unroll") for (int n = 0; n < 2; ++n) _Pragma("unroll") for (int k = 0; k < 2; ++k) dst[n][k] = *(const PG8_LAS bf16x8*)(lds + PG8_SB(b, h) + boff + n * 2048 + k * 1024); } while (0)
#define PG8_MMA(ai, bj, At, Bt) do { __builtin_amdgcn_s_setprio(1); _Pragma("unroll") for (int m = 0; m < 4; ++m) _Pragma("unroll") for (int n = 0; n < 2; ++n) _Pragma("unroll") for (int k = 0; k < 2; ++k) \
        acc[ai][bj][m][n] = __builtin_amdgcn_mfma_f32_16x16x32_bf16(Bt[n][k], At[m][k], acc[ai][bj][m][n], 0, 0, 0); __builtin_amdgcn_s_setprio(0); } while (0)
#define PG8_WAIT_V(n) asm volatile("s_waitcnt vmcnt(" #n ")" ::: "memory")
#define PG8_WAIT_L(n) asm volatile("s_waitcnt lgkmcnt(" #n ")" ::: "memory")
#define PG8_BAR __builtin_amdgcn_s_barrier()
#define PG8_SCHED __builtin_amdgcn_sched_barrier(0)
    Unit cur, nxt; int ui = 0;
    if (!S.next(0, cur)) return;
    f32x4 acc[2][2][4][2];
#pragma unroll
    for (int a = 0; a < 2; ++a)
#pragma unroll
        for (int b = 0; b < 2; ++b)
#pragma unroll
            for (int m = 0; m < 4; ++m)
#pragma unroll
                for (int n = 0; n < 2; ++n) acc[a][b][m][n] = (f32x4){0.f, 0.f, 0.f, 0.f};
    bf16x8 At[4][2], B0[2][2], B1[2][2];
    const char* cA = (const char*)g.A + (size_t)cur.pm * tstep; const char* cB = (const char*)g.Bt + (size_t)cur.pn * tstep;
    S.a_ready(cur);
    if constexpr (SP2) {
        PG8_STAGE(PG8_SB(0, 0), cB, voffB); PG8_STAGE(PG8_SB(0, 1), cB + hstep, voffB); PG8_STAGE(PG8_SA(0, 0), cA, voffA); PG8_STAGE(PG8_SA(0, 1), cA + hstep, voffA);
        if (wr == 1) PG8_BAR;
        PG8_WAIT_V(2); PG8_BAR;
        PG8_STAGE(PG8_SB(1, 0), cB + kstep, voffB); PG8_STAGE(PG8_SA(1, 0), cA + kstep, voffA); PG8_STAGE(PG8_SB(1, 1), cB + hstep + kstep, voffB);
        PG8_WAIT_V(6); PG8_BAR;
    } else {
        PG8_STAGE(PG8_SB(0, 0), cB, voffB); PG8_STAGE(PG8_SA(0, 0), cA, voffA); PG8_STAGE(PG8_SB(0, 1), cB + hstep, voffB); PG8_STAGE(PG8_SA(0, 1), cA + hstep, voffA);
        if (wr == 1) PG8_BAR;
        PG8_WAIT_V(4); PG8_BAR;
        PG8_STAGE(PG8_SB(1, 0), cB + kstep, voffB); PG8_STAGE(PG8_SA(1, 0), cA + kstep, voffA); PG8_STAGE(PG8_SB(1, 1), cB + hstep + kstep, voffB);
        PG8_WAIT_V(6); PG8_BAR;
    }
    for (;;) {
        const bool has_next = S.next(ui + 1, nxt);
        const char* nA = has_next ? (const char*)g.A + (size_t)nxt.pm * tstep : cA; const char* nB = has_next ? (const char*)g.Bt + (size_t)nxt.pn * tstep : cB;
        for (int t = 0; t < nt; t += 2) {
            const bool last = (t == nt - 2);
            const char* a1 = cA + (size_t)(t + 1) * kstep;
            const char* a2 = last ? nA : cA + (size_t)(t + 2) * kstep; const char* b2 = last ? nB : cB + (size_t)(t + 2) * kstep;
            const char* a3 = a2 + kstep; const char* b3 = b2 + kstep;
            if (last && has_next) S.a_ready(nxt);
            if constexpr (SP2) {
            PG8_LDB(B0, 0, 0); PG8_LDB(B1, 0, 1); PG8_SCHED; PG8_LDA(At, 0, 0); PG8_STAGE(PG8_SA(1, 1), a1 + hstep, voffA);
            PG8_WAIT_V(8); PG8_WAIT_L(0); PG8_BAR; PG8_MMA(0, 0, At, B0); PG8_MMA(0, 1, At, B1); PG8_BAR; PG8_SCHED;
            PG8_LDA(At, 0, 1); PG8_STAGE(PG8_SB(0, 0), b2, voffB); PG8_STAGE(PG8_SB(0, 1), b2 + hstep, voffB); PG8_STAGE(PG8_SA(0, 0), a2, voffA);
            PG8_WAIT_V(8); PG8_WAIT_L(0); PG8_BAR; PG8_MMA(1, 0, At, B0); PG8_MMA(1, 1, At, B1); PG8_BAR; PG8_SCHED;
            PG8_LDB(B0, 1, 0); PG8_LDB(B1, 1, 1); PG8_SCHED; PG8_LDA(At, 1, 0); PG8_STAGE(PG8_SA(0, 1), a2 + hstep, voffA);
            PG8_WAIT_V(8); PG8_WAIT_L(0); PG8_BAR; PG8_MMA(0, 0, At, B0); PG8_MMA(0, 1, At, B1); PG8_BAR; PG8_SCHED;
            PG8_LDA(At, 1, 1); PG8_STAGE(PG8_SB(1, 0), b3, voffB); PG8_STAGE(PG8_SB(1, 1), b3 + hstep, voffB); PG8_STAGE(PG8_SA(1, 0), a3, voffA);
            PG8_WAIT_V(8); PG8_WAIT_L(0); PG8_BAR; PG8_MMA(1, 0, At, B0); PG8_MMA(1, 1, At, B1); PG8_BAR; PG8_SCHED;
            } else {
            PG8_LDB(B0, 0, 0); PG8_SCHED; PG8_LDA(At, 0, 0); PG8_STAGE(PG8_SA(1, 1), a1 + hstep, voffA);
            PG8_WAIT_L(8); PG8_BAR; PG8_WAIT_L(0); PG8_MMA(0, 0, At, B0); PG8_BAR; PG8_SCHED;
            PG8_LDB(B1, 0, 1); PG8_STAGE(PG8_SB(0, 0), b2, voffB);
            PG8_BAR; PG8_WAIT_L(0); PG8_MMA(0, 1, At, B1); PG8_BAR;
            PG8_LDA(At, 0, 1); PG8_STAGE(PG8_SA(0, 0), a2, voffA);
            PG8_BAR; PG8_WAIT_L(0); PG8_MMA(1, 0, At, B0); PG8_BAR; PG8_SCHED;
            PG8_STAGE(PG8_SB(0, 1), b2 + hstep, voffB);
            PG8_WAIT_V(6); PG8_BAR; PG8_MMA(1, 1, At, B1); PG8_BAR;
            PG8_LDB(B0, 1, 0); PG8_SCHED; PG8_LDA(At, 1, 0); PG8_STAGE(PG8_SA(0, 1), a2 + hstep, voffA);
            PG8_WAIT_L(8); PG8_BAR; PG8_WAIT_L(0); PG8_MMA(0, 0, At, B0); PG8_BAR; PG8_SCHED;
            PG8_LDB(B1, 1, 1); PG8_STAGE(PG8_SB(1, 0), b3, voffB);
            PG8_BAR; PG8_WAIT_L(0); PG8_MMA(0, 1, At, B1); PG8_BAR;
            PG8_LDA(At, 1, 1); PG8_STAGE(PG8_SA(1, 0), a3, voffA);
            PG8_BAR; PG8_WAIT_L(0); PG8_MMA(1, 0, At, B0); PG8_BAR; PG8_SCHED;
            PG8_STAGE(PG8_SB(1, 1), b3 + hstep, voffB);
            PG8_WAIT_V(6); PG8_BAR; PG8_MMA(1, 1, At, B1); PG8_BAR;
            }
        }
        if constexpr (ALIGN_EPI) { if (wr == 0) PG8_BAR; }
        if constexpr (!Epi::AFTER_DRAIN) { E(acc, cur, wr, wc, fr, fq); S.done(cur); }
        if (!has_next) break;
#pragma unroll
        for (int a = 0; a < 2; ++a)
#pragma unroll
            for (int b = 0; b < 2; ++b)
#pragma unroll
                for (int m = 0; m < 4; ++m)
#pragma unroll
                    for (int n = 0; n < 2; ++n) acc[a][b][m][n] = (f32x4){0.f, 0.f, 0.f, 0.f};
        cur = nxt; cA = nA; cB = nB; ++ui;
        if constexpr (ALIGN_EPI) { if (wr == 1) PG8_BAR; }
    }
    PG8_WAIT_V(0);
    if constexpr (!ALIGN_EPI) { if (wr == 0) PG8_BAR; }
    PG8_BAR;
    if constexpr (Epi::AFTER_DRAIN) { E.fused(acc, cur, wr, wc, fr, fq, lds, wid, lane); S.done(cur); }
#undef PG8_SA
#undef PG8_SB
#undef PG8_STAGE
#undef PG8_LDA
#undef PG8_LDB
#undef PG8_MMA
#undef PG8_WAIT_V
#undef PG8_WAIT_L
#undef PG8_BAR
#undef PG8_SCHED
}
}

constexpr int NB = 8, SEQ = 4096, DM = 1024, T = NB * SEQ;
constexpr int NIN = 5912, NINP = 6144;
constexpr float LN_EPS = 1e-5f;
constexpr size_t MiB = 1u << 20;
constexpr size_t WS_CTL = 0, WS_WIN = 2 * MiB, WS_WA = 14 * MiB, WS_WB = 15 * MiB, WS_WO = 16 * MiB, WS_ROPE = 18 * MiB, WS_KCC = 19 * MiB, WS_MISC = 20 * MiB;
constexpr size_t WS_GATE = 32 * MiB, WS_DL = 35 * MiB, WS_KV = 36 * MiB, WS_XB = 84 * MiB, WS_QN = 148 * MiB, WS_ZA = 180 * MiB, WS_Y = 148 * MiB;
constexpr size_t WS_ZB = 212 * MiB, WS_GMA = 244 * MiB, WS_GMB = 308 * MiB, WS_OA = 372 * MiB, WS_OB = 404 * MiB, WS_FG = 436 * MiB, WS_END = 512 * MiB;
constexpr size_t KV_STRIDE = 8 * MiB;
constexpr size_t OUT_QF = 0, OUT_FB = 32 * MiB, OUT_IB = 64 * MiB;
constexpr size_t MISC_BIASP = 0, MISC_LB = 32768, MISC_C1 = 40960;
constexpr size_t WS_PP = 22 * MiB, WS_W1T = 30 * MiB;
constexpr int LDS_BYTES = 147456;

typedef unsigned short bf16_t;
typedef float f32x4 __attribute__((ext_vector_type(4)));
typedef unsigned u32x4 __attribute__((ext_vector_type(4)));
typedef unsigned u32x2 __attribute__((ext_vector_type(2)));
#define LAS __attribute__((address_space(3)))

__device__ __forceinline__ float bf2f(unsigned v) { return __uint_as_float(v << 16); }
__device__ __forceinline__ unsigned f2bf(float f) { unsigned u = __float_as_uint(f); return (u + 0x7fffu + ((u >> 16) & 1u)) >> 16; }
__device__ __forceinline__ unsigned pk2(float lo, float hi) { return f2bf(lo) | (f2bf(hi) << 16); }
__device__ __forceinline__ float sigmoidf_(float x) { return __builtin_amdgcn_rcpf(1.0f + __builtin_amdgcn_exp2f(-1.4426950408889634f * x)); }
__device__ __forceinline__ float siluf_(float x) { return x * sigmoidf_(x); }
__device__ __forceinline__ void unpack8(const u32x4 w, float* f) {
    f[0] = bf2f(w.x & 0xffffu); f[1] = __uint_as_float(w.x & 0xffff0000u); f[2] = bf2f(w.y & 0xffffu); f[3] = __uint_as_float(w.y & 0xffff0000u);
    f[4] = bf2f(w.z & 0xffffu); f[5] = __uint_as_float(w.z & 0xffff0000u); f[6] = bf2f(w.w & 0xffffu); f[7] = __uint_as_float(w.w & 0xffff0000u);
}

__host__ __device__ __forceinline__ int in_colmap(int n) {
    if (n < 1280) { if ((n >= 768 && n < 896) || (n >= 1024 && n < 1152)) { const int w = n & 63; return (n & ~63) + (w >> 1) + 32 * (w & 1); } return n; }
    if (n < 5888) return n + 24;
    if (n < 5912) return 1280 + (n - 5888);
    return -1;
}
__device__ const double ROPE_INVF[32] = {1.0, 0.7498942093324559, 0.5623413251903491, 0.4216965034285822, 0.31622776601683794, 0.23713737056616552, 0.1778279410038923, 0.1333521432163324, 0.1, 0.07498942093324558, 0.05623413251903491, 0.042169650342858224, 0.03162277660168379, 0.023713737056616554, 0.01778279410038923, 0.01333521432163324, 0.01, 0.007498942093324558, 0.005623413251903491, 0.004216965034285823, 0.0031622776601683794, 0.0023713737056616554, 0.0017782794100389228, 0.001333521432163324, 0.001, 0.0007498942093324559, 0.0005623413251903491, 0.00042169650342858224, 0.00031622776601683794, 0.00023713737056616554, 0.00017782794100389227, 0.0001333521432163324};

using pg8::Unit;
struct EpiIn {
    static constexpr bool PERM = true, AFTER_DRAIN = false;
    unsigned char* ws; unsigned char* ob;
    template <int ACT> __device__ __forceinline__ void rows(const f32x4 (&acc)[2][2][4][2], const f32x4 (&bv)[2][2], bf16_t* dst, int ld, int row0) const {
#pragma unroll
        for (int ai = 0; ai < 2; ++ai)
#pragma unroll
            for (int m = 0; m < 4; ++m) { bf16_t* rowp = dst + (size_t)(row0 + ai * 128 + m * 16) * ld;
#pragma unroll
                for (int bj = 0; bj < 2; ++bj) { f32x4 v0 = acc[ai][bj][m][0] + bv[bj][0], v1 = acc[ai][bj][m][1] + bv[bj][1];
                    if (ACT == 1) { for (int i = 0; i < 4; ++i) { v0[i] = siluf_(v0[i]); v1[i] = siluf_(v1[i]); } }
                    if (ACT == 2) { for (int i = 0; i < 4; ++i) { v0[i] = sigmoidf_(v0[i]); v1[i] = sigmoidf_(v1[i]); } }
                    u32x4 w; w.x = pg8::cvt_pk_bf16(v0[0], v0[1]); w.y = pg8::cvt_pk_bf16(v0[2], v0[3]); w.z = pg8::cvt_pk_bf16(v1[0], v1[1]); w.w = pg8::cvt_pk_bf16(v1[2], v1[3]);
                    *(u32x4*)(rowp + bj * 128) = w; } }
    }
    __device__ __forceinline__ void operator()(const f32x4 (&acc)[2][2][4][2], const Unit& u, int wr, int wc, int fr, int fq) const {
        const int pn = u.pn, row0 = u.pm * 256 + wr * 64 + fr, cl0 = wc * 32 + 8 * fq;
        const float* biasp = (const float*)(ws + WS_MISC + MISC_BIASP) + pn * 256 + cl0;
        f32x4 bv[2][2];
#pragma unroll
        for (int bj = 0; bj < 2; ++bj)
#pragma unroll
            for (int n = 0; n < 2; ++n) bv[bj][n] = *(const f32x4*)(biasp + bj * 128 + 4 * n);
        if (pn < 2) { rows<0>(acc, bv, (bf16_t*)(ws + WS_QN) + pn * 256 + cl0, 512, row0); return; }
        if (pn < 5) {
            bf16_t* kb = (bf16_t*)(ws + WS_KV + (size_t)(2 * (pn - 2)) * KV_STRIDE); bf16_t* vb = (bf16_t*)(ws + WS_KV + (size_t)(2 * (pn - 2) + 1) * KV_STRIDE);
            const float* cosT = (const float*)(ws + WS_ROPE); const float* sinT = cosT + 4096 * 32;
            const int g = cl0 >> 6, w = cl0 & 63;
#pragma unroll
            for (int ai = 0; ai < 2; ++ai)
#pragma unroll
                for (int m = 0; m < 4; ++m) { const int r = row0 + ai * 128 + m * 16, b = r >> 12, t = r & 4095; const size_t ro = ((size_t)(b * 2 + g) * 4096 + t) * 64;
                    { f32x4 v0 = acc[ai][0][m][0] + bv[0][0], v1 = acc[ai][0][m][1] + bv[0][1];
                      if (pn > 2) { const int i0 = w >> 1; const f32x4 c = *(const f32x4*)(cosT + t * 32 + i0), s = *(const f32x4*)(sinT + t * 32 + i0);
                          const f32x4 x1 = {v0[0], v0[2], v1[0], v1[2]}, x2 = {v0[1], v0[3], v1[1], v1[3]};
                          const f32x4 lo = x1 * c - x2 * s, hi = x2 * c + x1 * s;
                          u32x2 a, bq; a.x = pg8::cvt_pk_bf16(lo[0], lo[1]); a.y = pg8::cvt_pk_bf16(lo[2], lo[3]); bq.x = pg8::cvt_pk_bf16(hi[0], hi[1]); bq.y = pg8::cvt_pk_bf16(hi[2], hi[3]);
                          *(u32x2*)(kb + ro + i0) = a; *(u32x2*)(kb + ro + 32 + i0) = bq;
                      } else { u32x4 wv; wv.x = pg8::cvt_pk_bf16(v0[0], v0[1]); wv.y = pg8::cvt_pk_bf16(v0[2], v0[3]); wv.z = pg8::cvt_pk_bf16(v1[0], v1[1]); wv.w = pg8::cvt_pk_bf16(v1[2], v1[3]); *(u32x4*)(kb + ro + w) = wv; } }
                    { const f32x4 v0 = acc[ai][1][m][0] + bv[1][0], v1 = acc[ai][1][m][1] + bv[1][1];
                      u32x4 wv; wv.x = pg8::cvt_pk_bf16(v0[0], v0[1]); wv.y = pg8::cvt_pk_bf16(v0[2], v0[3]); wv.z = pg8::cvt_pk_bf16(v1[0], v1[1]); wv.w = pg8::cvt_pk_bf16(v1[2], v1[3]); *(u32x4*)(vb + ro + w) = wv; } }
            return; }
        if (pn < 7)  { rows<1>(acc, bv, (bf16_t*)(ws + WS_ZA) + (pn - 5) * 256 + cl0, 512, row0); return; }
        if (pn < 9)  { rows<1>(acc, bv, (bf16_t*)(ob + OUT_QF) + (pn - 7) * 256 + cl0, 512, row0); return; }
        if (pn < 11) { rows<0>(acc, bv, (bf16_t*)(ob + OUT_FB) + (pn - 9) * 256 + cl0, 512, row0); return; }
        if (pn < 13) { rows<0>(acc, bv, (bf16_t*)(ob + OUT_IB) + (pn - 11) * 256 + cl0, 512, row0); return; }
        if (pn < 15) { rows<1>(acc, bv, (bf16_t*)(ws + WS_ZB) + (pn - 13) * 256 + cl0, 512, row0); return; }
        if (pn < 19) { rows<2>(acc, bv, (bf16_t*)(ws + WS_GMA) + (pn - 15) * 256 + cl0, 1024, row0); return; }
        if (pn < 23) { rows<2>(acc, bv, (bf16_t*)(ws + WS_GMB) + (pn - 19) * 256 + cl0, 1024, row0); return; }
        if (cl0 < 24) {
            float* gt = (float*)(ws + WS_GATE);
#pragma unroll
            for (int ai = 0; ai < 2; ++ai)
#pragma unroll
                for (int m = 0; m < 4; ++m) { const int r = row0 + ai * 128 + m * 16; f32x4 v0 = acc[ai][0][m][0] + bv[0][0], v1 = acc[ai][0][m][1] + bv[0][1];
                    for (int i = 0; i < 4; ++i) { v0[i] = sigmoidf_(v0[i]); v1[i] = sigmoidf_(v1[i]); }
                    *(f32x4*)(gt + (size_t)r * 24 + cl0) = v0; *(f32x4*)(gt + (size_t)r * 24 + cl0 + 4) = v1; } }
    }
};
struct EpiYA {
    static constexpr bool PERM = true, AFTER_DRAIN = false;
    const bf16_t* gate; float* ya;
    __device__ __forceinline__ void operator()(const f32x4 (&acc)[2][2][4][2], const Unit& u, int wr, int wc, int fr, int fq) const {
        const int row0 = u.pm * 256 + wr * 64 + fr, col0 = u.pn * 256 + wc * 32 + 8 * fq;
#pragma unroll
        for (int ai = 0; ai < 2; ++ai)
#pragma unroll
            for (int m = 0; m < 4; ++m)
#pragma unroll
                for (int bj = 0; bj < 2; ++bj) { const size_t off = (size_t)(row0 + ai * 128 + m * 16) * 1024 + col0 + bj * 128;
                    float g[8]; unpack8(*(const u32x4*)(gate + off), g);
                    f32x4 o0 = acc[ai][bj][m][0], o1 = acc[ai][bj][m][1];
                    for (int i = 0; i < 4; ++i) { o0[i] *= g[i]; o1[i] *= g[4 + i]; }
                    *(f32x4*)(ya + off) = o0; *(f32x4*)(ya + off + 4) = o1; }
    }
};
struct EpiYB {
    static constexpr bool PERM = true, AFTER_DRAIN = false;
    const bf16_t* gate; const float* ya; bf16_t* y;
    __device__ __forceinline__ void operator()(const f32x4 (&acc)[2][2][4][2], const Unit& u, int wr, int wc, int fr, int fq) const {
        const int row0 = u.pm * 256 + wr * 64 + fr, col0 = u.pn * 256 + wc * 32 + 8 * fq;
#pragma unroll
        for (int ai = 0; ai < 2; ++ai)
#pragma unroll
            for (int m = 0; m < 4; ++m)
#pragma unroll
                for (int bj = 0; bj < 2; ++bj) { const size_t off = (size_t)(row0 + ai * 128 + m * 16) * 1024 + col0 + bj * 128;
                    float g[8]; unpack8(*(const u32x4*)(gate + off), g);
                    f32x4 o0 = *(const f32x4*)(ya + off), o1 = *(const f32x4*)(ya + off + 4);
                    for (int i = 0; i < 4; ++i) { o0[i] += g[i] * acc[ai][bj][m][0][i]; o1[i] += g[4 + i] * acc[ai][bj][m][1][i]; }
                    u32x4 w; w.x = pg8::cvt_pk_bf16(o0[0], o0[1]); w.y = pg8::cvt_pk_bf16(o0[2], o0[3]); w.z = pg8::cvt_pk_bf16(o1[0], o1[1]); w.w = pg8::cvt_pk_bf16(o1[2], o1[3]);
                    *(u32x4*)(y + off) = w; }
    }
};
struct EpiOut {
    static constexpr bool PERM = true, AFTER_DRAIN = false;
    const float* x; float* out; float alpha;
    __device__ __forceinline__ void operator()(const f32x4 (&acc)[2][2][4][2], const Unit& u, int wr, int wc, int fr, int fq) const {
        const int row0 = u.pm * 256 + wr * 64 + fr, col0 = u.pn * 256 + wc * 32 + 8 * fq;
#pragma unroll
        for (int ai = 0; ai < 2; ++ai)
#pragma unroll
            for (int m = 0; m < 4; ++m)
#pragma unroll
                for (int bj = 0; bj < 2; ++bj) { const size_t off = (size_t)(row0 + ai * 128 + m * 16) * 1024 + col0 + bj * 128;
                    const f32x4 x0 = *(const f32x4*)(x + off), x1 = *(const f32x4*)(x + off + 4);
                    *(f32x4*)(out + off) = x0 * alpha + acc[ai][bj][m][0]; *(f32x4*)(out + off + 4) = x1 * alpha + acc[ai][bj][m][1]; }
    }
};

template <class CMap> __device__ __forceinline__ void transpose_item(const float* W, int K, int ldw, int Nn, bf16_t* WT, LAS float* scr, int item, int lane, const CMap& cmap) {
    const int nblk = Nn / 32, kb = item / nblk, nb = item % nblk, k0 = 64 * kb, n0 = 32 * nb;
    const int oc = cmap(n0 + (lane & 31));
#pragma unroll 8
    for (int i = 0; i < 32; ++i) { const int kk = 2 * i + (lane >> 5); scr[kk * 33 + (lane & 31)] = oc >= 0 ? W[(size_t)(k0 + kk) * ldw + oc] : 0.f; }
    asm volatile("s_waitcnt lgkmcnt(0)" ::: "memory");
    const int c = lane & 7;
#pragma unroll
    for (int j = 0; j < 4; ++j) { const int n = (lane >> 3) + 8 * j; const LAS float* s = scr + (8 * c) * 33 + n;
        u32x4 o; o.x = pk2(s[0 * 33], s[1 * 33]); o.y = pk2(s[2 * 33], s[3 * 33]); o.z = pk2(s[4 * 33], s[5 * 33]); o.w = pk2(s[6 * 33], s[7 * 33]);
        *(u32x4*)(WT + (size_t)(n0 + n) * K + k0 + 8 * c) = o; }
    asm volatile("s_waitcnt lgkmcnt(0)" ::: "memory");
}
struct CMapIn { __device__ __forceinline__ int operator()(int n) const { return in_colmap(n); } };
struct CMapId { __device__ __forceinline__ int operator()(int n) const { return n; } };


typedef short bf16x8 __attribute__((ext_vector_type(8)));
typedef short s16x4 __attribute__((ext_vector_type(4)));
typedef float f32x16 __attribute__((ext_vector_type(16)));
#define MFMA32(a, b, c) __builtin_amdgcn_mfma_f32_32x32x16_bf16((a), (b), (c), 0, 0, 0)
__device__ __forceinline__ int crow(int r, int hi) { return (r & 3) + 8 * (r >> 2) + 4 * hi; }
__device__ __forceinline__ unsigned cvtpk(float lo, float hi) { return pg8::cvt_pk_bf16(lo, hi); }
__device__ __forceinline__ bf16x8 ld8(const LAS unsigned char* p) { return *(const LAS bf16x8*)p; }
__device__ __forceinline__ bf16x8 ld4x2(const LAS unsigned char* p0, const LAS unsigned char* p1) { const s16x4 a = *(const LAS s16x4*)p0, b = *(const LAS s16x4*)p1; return (bf16x8){a[0], a[1], a[2], a[3], b[0], b[1], b[2], b[3]}; }
__device__ __forceinline__ bf16x8 accfrag(const f32x16& p, int s) {
    u32x4 w;
    if (s == 0) { w.x = cvtpk(p[0], p[1]); w.y = cvtpk(p[2], p[3]); w.z = cvtpk(p[4], p[5]); w.w = cvtpk(p[6], p[7]); }
    else { w.x = cvtpk(p[8], p[9]); w.y = cvtpk(p[10], p[11]); w.z = cvtpk(p[12], p[13]); w.w = cvtpk(p[14], p[15]); }
    return __builtin_bit_cast(bf16x8, w);
}
#define BLOCK_SYNC() __syncthreads()

constexpr int H_PKD = 144, H_PQE = 272;
constexpr int HL_VT = 0, HL_KDT = 18432, HL_TOT = 36864, HL_QE = 40960, HL_KE = 58368, HL_SS = 75776, HL_OT = 76800, HL_END = 76800 + 64 * 132 * 4;
static_assert(HL_END <= 131072, "hgrn lds");

__device__ __forceinline__ void hgrn_gate(const bf16_t* FB, const float* LBp, int r0, int colbase, int seg, int cp, float (&pre)[2][8], float (&kk)[2][8], LAS unsigned char* lds) {
    const float lb0 = LBp[colbase + 2 * cp], lb1 = LBp[colbase + 2 * cp + 1];
    float a0 = 0.f, a1 = 0.f;
#pragma unroll
    for (int i = 0; i < 8; ++i) { const unsigned w = *(const unsigned*)(FB + (size_t)(r0 + seg * 8 + i) * 512 + colbase + 2 * cp);
        const float s0 = sigmoidf_(bf2f(w & 0xffffu)), s1 = sigmoidf_(__uint_as_float(w & 0xffff0000u));
        const float f0 = lb0 + (1.f - lb0) * s0, f1 = lb1 + (1.f - lb1) * s1;
        a0 += __logf(f0); a1 += __logf(f1); pre[0][i] = a0; pre[1][i] = a1; kk[0][i] = (1.f - lb0) * (1.f - s0); kk[1][i] = (1.f - lb1) * (1.f - s1); }
    LAS float* tot = (LAS float*)(lds + HL_TOT);
    tot[seg * 128 + 2 * cp] = a0; tot[seg * 128 + 2 * cp + 1] = a1;
}
__device__ __forceinline__ void hgrn_stage_vt(const bf16_t* IB, int r0, int colbase, int tid, LAS unsigned char* lds) {
    const int c = tid & 63, ch = tid >> 6;
#pragma unroll
    for (int q = 0; q < 2; ++q) { const u32x4 w = *(const u32x4*)(IB + (size_t)(r0 + c) * 512 + colbase + 8 * (ch + 8 * q));
        LAS unsigned short* d = (LAS unsigned short*)(lds + HL_VT + (size_t)(8 * (ch + 8 * q)) * H_PKD + 2 * c);
        d[0 * (H_PKD / 2)] = (unsigned short)(w.x & 0xffffu); d[1 * (H_PKD / 2)] = (unsigned short)(w.x >> 16); d[2 * (H_PKD / 2)] = (unsigned short)(w.y & 0xffffu); d[3 * (H_PKD / 2)] = (unsigned short)(w.y >> 16);
        d[4 * (H_PKD / 2)] = (unsigned short)(w.z & 0xffffu); d[5 * (H_PKD / 2)] = (unsigned short)(w.z >> 16); d[6 * (H_PKD / 2)] = (unsigned short)(w.w & 0xffffu); d[7 * (H_PKD / 2)] = (unsigned short)(w.w >> 16); }
}
__device__ __forceinline__ void hgrn_offsets(int seg, int cp, float (&off)[2], float (&last)[2], LAS unsigned char* lds) {
    const LAS float* tot = (const LAS float*)(lds + HL_TOT);
    off[0] = off[1] = 0.f; last[0] = last[1] = 0.f;
#pragma unroll
    for (int s = 0; s < 8; ++s) { const float t0 = tot[s * 128 + 2 * cp], t1 = tot[s * 128 + 2 * cp + 1]; if (s < seg) { off[0] += t0; off[1] += t1; } last[0] += t0; last[1] += t1; }
}
__device__ __forceinline__ void hgrn_h1_unit(int unit, unsigned char* ws, unsigned char* ob, LAS unsigned char* lds, int tid, int lane, int wave) {
    const int bh = unit >> 6, n = unit & 63, b = bh >> 2, h = bh & 3, r0 = b * SEQ + n * 64, colbase = h * 128;
    const bf16_t* FB = (const bf16_t*)(ob + OUT_FB); const bf16_t* IB = (const bf16_t*)(ob + OUT_IB); const float* LBp = (const float*)(ws + WS_MISC + MISC_LB);
    float pre[2][8], kk[2][8], off[2], last[2];
    hgrn_gate(FB, LBp, r0, colbase, wave, lane, pre, kk, lds);
    hgrn_stage_vt(IB, r0, colbase, tid, lds);
    BLOCK_SYNC();
    hgrn_offsets(wave, lane, off, last, lds);
#pragma unroll
    for (int e = 0; e < 2; ++e) { float v[8];
#pragma unroll
        for (int i = 0; i < 8; ++i) v[i] = kk[e][i] * __expf(last[e] - (off[e] + pre[e][i]));
        u32x4 w; w.x = cvtpk(v[0], v[1]); w.y = cvtpk(v[2], v[3]); w.z = cvtpk(v[4], v[5]); w.w = cvtpk(v[6], v[7]);
        *(LAS u32x4*)(lds + HL_KDT + (size_t)(2 * lane + e) * H_PKD + 16 * wave) = w; }
    if (wave == 0) { float* dl = (float*)(ws + WS_DL) + (size_t)unit * 128 + 2 * lane; dl[0] = __expf(last[0]); dl[1] = __expf(last[1]); }
    BLOCK_SYNC();
    const int r = lane & 31, hh = lane >> 5, dvt = wave >> 1, dk0 = 2 * (wave & 1);
    f32x16 acc[2]; acc[0] = (f32x16){}; acc[1] = (f32x16){};
#pragma unroll
    for (int ks = 0; ks < 4; ++ks) { const bf16x8 a = ld8(lds + HL_VT + (size_t)(32 * dvt + r) * H_PKD + 32 * ks + 16 * hh);
#pragma unroll
        for (int t = 0; t < 2; ++t) { const bf16x8 bq = ld8(lds + HL_KDT + (size_t)(32 * (dk0 + t) + r) * H_PKD + 32 * ks + 16 * hh); acc[t] = MFMA32(a, bq, acc[t]); } }
    bf16_t* US = (bf16_t*)(ws + WS_XB) + (size_t)unit * 16384;
#pragma unroll
    for (int t = 0; t < 2; ++t)
#pragma unroll
        for (int g = 0; g < 16; ++g) US[(size_t)(32 * dvt + crow(g, hh)) * 128 + 32 * (dk0 + t) + r] = (bf16_t)f2bf(acc[t][g]);
    BLOCK_SYNC();
}
__device__ __forceinline__ void hgrn_h2(unsigned char* ws, int gtid, int ngt) {
    for (int e = gtid; e < 32 * 4096; e += ngt) { const int bh = e >> 12, q4 = e & 4095;
        bf16_t* us = (bf16_t*)(ws + WS_XB) + (size_t)bh * 64 * 16384 + 4 * q4; const float* dl = (const float*)(ws + WS_DL) + (size_t)bh * 64 * 128 + ((4 * q4) & 127);
        f32x4 st = {0.f, 0.f, 0.f, 0.f};
        for (int nb = 0; nb < 64; nb += 8) { u32x2 u[8]; f32x4 d[8];
#pragma unroll
            for (int i = 0; i < 8; ++i) { u[i] = *(const u32x2*)(us + (size_t)(nb + i) * 16384); d[i] = *(const f32x4*)(dl + (size_t)(nb + i) * 128); }
#pragma unroll
            for (int i = 0; i < 8; ++i) { u32x2 o; o.x = cvtpk(st[0], st[1]); o.y = cvtpk(st[2], st[3]); *(u32x2*)(us + (size_t)(nb + i) * 16384) = o;
                st[0] = d[i][0] * st[0] + bf2f(u[i].x & 0xffffu); st[1] = d[i][1] * st[1] + __uint_as_float(u[i].x & 0xffff0000u);
                st[2] = d[i][2] * st[2] + bf2f(u[i].y & 0xffffu); st[3] = d[i][3] * st[3] + __uint_as_float(u[i].y & 0xffff0000u); } } }
}
__device__ __forceinline__ void hgrn_h3_unit(int unit, unsigned char* ws, unsigned char* ob, const float* gnorm, LAS unsigned char* lds, int tid, int lane, int wave) {
    const int bh = unit >> 6, n = unit & 63, b = bh >> 2, h = bh & 3, r0 = b * SEQ + n * 64, colbase = h * 128;
    const bf16_t* FB = (const bf16_t*)(ob + OUT_FB); const bf16_t* IB = (const bf16_t*)(ob + OUT_IB); const bf16_t* QF = (const bf16_t*)(ob + OUT_QF); const float* LBp = (const float*)(ws + WS_MISC + MISC_LB);
    float pre[2][8], kk[2][8], off[2], last[2];
    hgrn_gate(FB, LBp, r0, colbase, wave, lane, pre, kk, lds);
    hgrn_stage_vt(IB, r0, colbase, tid, lds);
    unsigned qw[8];
#pragma unroll
    for (int i = 0; i < 8; ++i) qw[i] = *(const unsigned*)(QF + (size_t)(r0 + wave * 8 + i) * 512 + colbase + 2 * lane);
    BLOCK_SYNC();
    hgrn_offsets(wave, lane, off, last, lds);
#pragma unroll
    for (int i = 0; i < 8; ++i) { const float b0 = off[0] + pre[0][i], b1 = off[1] + pre[1][i];
        const float q0 = bf2f(qw[i] & 0xffffu) * __expf(b0), q1 = __uint_as_float(qw[i] & 0xffff0000u) * __expf(b1);
        const float k0 = kk[0][i] * __expf(-b0), k1 = kk[1][i] * __expf(-b1);
        *(LAS unsigned*)(lds + HL_QE + (size_t)(wave * 8 + i) * H_PQE + 4 * lane) = cvtpk(q0, q1);
        *(LAS unsigned*)(lds + HL_KE + (size_t)(wave * 8 + i) * H_PQE + 4 * lane) = cvtpk(k0, k1); }
    BLOCK_SYNC();
    const int r = lane & 31, hh = lane >> 5, dvt = wave >> 1, ct = wave & 1;
    f32x16 pt[2]; pt[0] = (f32x16){}; pt[1] = (f32x16){};
    f32x16 o = (f32x16){};
    const bf16_t* ST = (const bf16_t*)(ws + WS_XB) + (size_t)unit * 16384 + (size_t)(32 * dvt + r) * 128 + 8 * hh;
#pragma unroll
    for (int ks = 0; ks < 8; ++ks) { const bf16x8 bq = ld8(lds + HL_QE + (size_t)(32 * ct + r) * H_PQE + 32 * ks + 16 * hh);
        const bf16x8 a0 = ld8(lds + HL_KE + (size_t)r * H_PQE + 32 * ks + 16 * hh); pt[0] = MFMA32(a0, bq, pt[0]);
        if (ct == 1) { const bf16x8 a1 = ld8(lds + HL_KE + (size_t)(32 + r) * H_PQE + 32 * ks + 16 * hh); pt[1] = MFMA32(a1, bq, pt[1]); }
        const bf16x8 as = *(const bf16x8*)(ST + 16 * ks); o = MFMA32(as, bq, o); }
#pragma unroll
    for (int g = 0; g < 16; ++g) { if (crow(g, hh) > r) { if (ct == 0) pt[0][g] = 0.f; else pt[1][g] = 0.f; } }
#pragma unroll
    for (int st = 0; st < 2; ++st) { if (st <= ct) {
#pragma unroll
            for (int s2 = 0; s2 < 2; ++s2) { const LAS unsigned char* vp = lds + HL_VT + (size_t)(32 * dvt + r) * H_PKD + 2 * (32 * st + 16 * s2 + 4 * hh);
                const bf16x8 a = ld4x2(vp, vp + 16); o = MFMA32(a, accfrag(pt[st], s2), o); } } }
    float ss = 0.f;
#pragma unroll
    for (int g = 0; g < 16; ++g) ss += o[g] * o[g];
    ss += __shfl_xor(ss, 32);
    LAS float* SS = (LAS float*)(lds + HL_SS);
    if (hh == 0) SS[dvt * 64 + 32 * ct + r] = ss;
    BLOCK_SYNC();
    const float tot = SS[32 * ct + r] + SS[64 + 32 * ct + r] + SS[128 + 32 * ct + r] + SS[192 + 32 * ct + r];
    const float rstd = 1.0f / sqrtf(tot * (1.f / 128.f) + LN_EPS);
    LAS float* OT = (LAS float*)(lds + HL_OT);
#pragma unroll
    for (int g = 0; g < 16; ++g) { const int dv = 32 * dvt + crow(g, hh); OT[(32 * ct + r) * 132 + dv] = o[g] * rstd * gnorm[colbase + dv]; }
    BLOCK_SYNC();
    { const int c = tid >> 3, ch = tid & 7; const LAS float* src = OT + c * 132 + 16 * ch;
      const bf16_t* zb = (const bf16_t*)(ws + WS_ZB) + (size_t)(r0 + c) * 512 + colbase + 16 * ch; bf16_t* dst = (bf16_t*)(ws + WS_OB) + (size_t)(r0 + c) * 512 + colbase + 16 * ch;
#pragma unroll
      for (int q = 0; q < 2; ++q) { float z[8]; unpack8(*(const u32x4*)(zb + 8 * q), z); const f32x4 x0 = *(const LAS f32x4*)(src + 8 * q), x1 = *(const LAS f32x4*)(src + 8 * q + 4);
          u32x4 w; w.x = cvtpk(x0[0] * z[0], x0[1] * z[1]); w.y = cvtpk(x0[2] * z[2], x0[3] * z[3]); w.z = cvtpk(x1[0] * z[4], x1[1] * z[5]); w.w = cvtpk(x1[2] * z[6], x1[3] * z[7]); *(u32x4*)(dst + 8 * q) = w; } }
    BLOCK_SYNC();
}


constexpr int N_P = 144;
constexpr int NL_K = 0, NL_V = 18432, NL_IMPA = 36864, NL_IMPB = 53248, NL_SEL = 69632, NL_OT = 70144, NL_END = 70144 + 8 * 32 * 65 * 4;
static_assert(NL_END <= LDS_BYTES, "nsa lds");
constexpr float NSA_C2 = 0.125f * 1.4426950408889634f;
struct NsaStage { u32x4 k, v; };
__device__ __forceinline__ void nsa_load(NsaStage& s, const bf16_t* Kb, const bf16_t* Vb, int tile, int tid) {
    s.k = *(const u32x4*)(Kb + (size_t)(tile * 64 + (tid >> 3)) * 64 + 8 * (tid & 7));
    s.v = *(const u32x4*)(Vb + (size_t)(tile * 64 + (tid & 63)) * 64 + 8 * (tid >> 6));
}
__device__ __forceinline__ void nsa_store(const NsaStage& s, LAS unsigned char* lds, int buf, int tid) {
    *(LAS u32x4*)(lds + NL_K + buf * 9216 + (tid >> 3) * N_P + 16 * (tid & 7)) = s.k;
    LAS unsigned short* d = (LAS unsigned short*)(lds + NL_V + buf * 9216 + (8 * (tid >> 6)) * N_P + 2 * (tid & 63));
    d[0 * (N_P / 2)] = (unsigned short)(s.v.x & 0xffffu); d[1 * (N_P / 2)] = (unsigned short)(s.v.x >> 16); d[2 * (N_P / 2)] = (unsigned short)(s.v.y & 0xffffu); d[3 * (N_P / 2)] = (unsigned short)(s.v.y >> 16);
    d[4 * (N_P / 2)] = (unsigned short)(s.v.z & 0xffffu); d[5 * (N_P / 2)] = (unsigned short)(s.v.z >> 16); d[6 * (N_P / 2)] = (unsigned short)(s.v.w & 0xffffu); d[7 * (N_P / 2)] = (unsigned short)(s.v.w >> 16);
}
__device__ __forceinline__ void nsa_scores(f32x16& p0, f32x16& p1, const LAS unsigned char* kb, const bf16x8 (&qf)[4], int r32, int hi) {
    p0 = (f32x16){}; p1 = (f32x16){};
#pragma unroll
    for (int s = 0; s < 4; ++s) { const bf16x8 a0 = ld8(kb + r32 * N_P + 32 * s + 16 * hi), a1 = ld8(kb + (32 + r32) * N_P + 32 * s + 16 * hi); p0 = MFMA32(a0, qf[s], p0); p1 = MFMA32(a1, qf[s], p1); }
}
__device__ __forceinline__ void nsa_pv(f32x16 (&o)[2], const f32x16& p0, const f32x16& p1, const LAS unsigned char* vb, int r32, int hi) {
#pragma unroll
    for (int kh = 0; kh < 2; ++kh)
#pragma unroll
        for (int s2 = 0; s2 < 2; ++s2) { const bf16x8 bf = accfrag(kh ? p1 : p0, s2);
#pragma unroll
            for (int dt = 0; dt < 2; ++dt) { const LAS unsigned char* vp = vb + (32 * dt + r32) * N_P + 2 * (32 * kh + 16 * s2 + 4 * hi); o[dt] = MFMA32(ld4x2(vp, vp + 16), bf, o[dt]); } }
}
__device__ __forceinline__ void nsa_softmax_step(f32x16& p0, f32x16& p1, float& m, float& l, f32x16 (&o)[2]) {
    float mx = p0[0];
#pragma unroll
    for (int g = 1; g < 16; ++g) mx = fmaxf(mx, p0[g]);
#pragma unroll
    for (int g = 0; g < 16; ++g) mx = fmaxf(mx, p1[g]);
    mx = fmaxf(mx, __shfl_xor(mx, 32));
    const float mn = fmaxf(m, mx), al = __builtin_amdgcn_exp2f(m - mn);
    float rs = 0.f;
#pragma unroll
    for (int g = 0; g < 16; ++g) { p0[g] = __builtin_amdgcn_exp2f(p0[g] - mn); p1[g] = __builtin_amdgcn_exp2f(p1[g] - mn); rs += p0[g] + p1[g]; }
    rs += __shfl_xor(rs, 32);
    l = l * al + rs; m = mn;
#pragma unroll
    for (int g = 0; g < 16; ++g) { o[0][g] *= al; o[1][g] *= al; }
}
#define NSA_LOOP_BEGIN(Kb, Vb, T0, NT) { NsaStage sg_; nsa_load(sg_, (Kb), (Vb), (T0), tid); nsa_store(sg_, lds, 0, tid); BLOCK_SYNC(); \
    for (int it_ = 0; it_ < (NT); ++it_) { const int tile = (T0) + it_, buf_ = it_ & 1; if (it_ + 1 < (NT)) nsa_load(sg_, (Kb), (Vb), tile + 1, tid); \
        const LAS unsigned char* kb_ = lds + NL_K + buf_ * 9216; const LAS unsigned char* vb_ = lds + NL_V + buf_ * 9216; (void)kb_; (void)vb_;
#define NSA_LOOP_END(NT) if (it_ + 1 < (NT)) nsa_store(sg_, lds, buf_ ^ 1, tid); BLOCK_SYNC(); } }

__device__ __forceinline__ void nsa_unit(int bg, int qt, unsigned char* ws, LAS unsigned char* lds, int tid, int lane, int wave) {
    const int b = bg >> 1, g = bg & 1, r32 = lane & 31, hi = lane >> 5, tl = r32 & 7, head = r32 >> 3, tok0 = qt * 64, tw = 8 * wave + tl, t = tok0 + tw, r = b * SEQ + t, hg = g * 4 + head;
    const bf16_t* KC = (const bf16_t*)(ws + WS_KCC) + (size_t)bg * 256 * 64; const bf16_t* VC = (const bf16_t*)(ws + WS_KCC + MiB / 2) + (size_t)bg * 256 * 64;
    const bf16_t* KS = (const bf16_t*)(ws + WS_KV + 2 * KV_STRIDE) + (size_t)bg * 4096 * 64; const bf16_t* VS = (const bf16_t*)(ws + WS_KV + 3 * KV_STRIDE) + (size_t)bg * 4096 * 64;
    const bf16_t* KW = (const bf16_t*)(ws + WS_KV + 4 * KV_STRIDE) + (size_t)bg * 4096 * 64; const bf16_t* VW = (const bf16_t*)(ws + WS_KV + 5 * KV_STRIDE) + (size_t)bg * 4096 * 64;
    bf16x8 qf[4];
#pragma unroll
    for (int s = 0; s < 4; ++s) qf[s] = *(const bf16x8*)((const bf16_t*)(ws + WS_QN) + (size_t)r * 512 + hg * 64 + 16 * s + 8 * hi);
    const float* gp = (const float*)(ws + WS_GATE) + (size_t)r * 24 + hg * 3;
    const float g0 = gp[0], g1 = gp[1], g2 = gp[2];
    LAS float* OT = (LAS float*)(lds + NL_OT) + wave * 32 * 65 + r32 * 65;
    f32x16 o[2], p0, p1;
    const int nv = t >= 31 ? ((t - 31) / 16 + 1 > 255 ? 255 : (t - 31) / 16 + 1) : 0;
    const int tlast = tok0 + 63, nvmax = tlast >= 31 ? ((tlast - 31) / 16 + 1 > 255 ? 255 : (tlast - 31) / 16 + 1) : 0, ntc = (nvmax + 63) >> 6;
    float m = -1e30f, l = 0.f;
    if (ntc > 0) {
        NSA_LOOP_BEGIN(KC, VC, 0, ntc)
            nsa_scores(p0, p1, kb_, qf, r32, hi);
            float mx = -INFINITY;
#pragma unroll
            for (int gq = 0; gq < 16; ++gq) { const int n0 = tile * 64 + crow(gq, hi); p0[gq] = n0 < nv ? p0[gq] * NSA_C2 : -INFINITY; p1[gq] = n0 + 32 < nv ? p1[gq] * NSA_C2 : -INFINITY; mx = fmaxf(mx, fmaxf(p0[gq], p1[gq])); }
            mx = fmaxf(mx, __shfl_xor(mx, 32));
            const float mn = fmaxf(m, mx); float rs = 0.f;
#pragma unroll
            for (int gq = 0; gq < 16; ++gq) rs += __builtin_amdgcn_exp2f(p0[gq] - mn) + __builtin_amdgcn_exp2f(p1[gq] - mn);
            rs += __shfl_xor(rs, 32);
            l = l * __builtin_amdgcn_exp2f(m - mn) + rs; m = mn;
        NSA_LOOP_END(ntc)
        const float rl = l > 0.f ? 1.f / l : 0.f;
        o[0] = (f32x16){}; o[1] = (f32x16){};
        LAS float* impA = (LAS float*)(lds + NL_IMPA) + (8 * wave + tl) * 64; LAS float* impB = (LAS float*)(lds + NL_IMPB) + (8 * wave + tl) * 64;
        NSA_LOOP_BEGIN(KC, VC, 0, ntc)
            nsa_scores(p0, p1, kb_, qf, r32, hi);
#pragma unroll
            for (int gq = 0; gq < 16; ++gq) { const int n0 = tile * 64 + crow(gq, hi); p0[gq] = n0 < nv ? __builtin_amdgcn_exp2f(p0[gq] * NSA_C2 - m) * rl : 0.f; p1[gq] = n0 + 32 < nv ? __builtin_amdgcn_exp2f(p1[gq] * NSA_C2 - m) * rl : 0.f; }
#pragma unroll
            for (int rq = 0; rq < 4; ++rq) {
                float qa = (p0[4 * rq] + p0[4 * rq + 1]) + (p0[4 * rq + 2] + p0[4 * rq + 3]), la = p0[4 * rq + 3];
                float qb = (p1[4 * rq] + p1[4 * rq + 1]) + (p1[4 * rq + 2] + p1[4 * rq + 3]), lb = p1[4 * rq + 3];
                qa += __shfl_xor(qa, 8); qa += __shfl_xor(qa, 16); la += __shfl_xor(la, 8); la += __shfl_xor(la, 16);
                qb += __shfl_xor(qb, 8); qb += __shfl_xor(qb, 16); lb += __shfl_xor(lb, 8); lb += __shfl_xor(lb, 16);
                if (head == 0) { const int j0 = tile * 16 + 2 * rq + hi; impA[j0] = qa; impA[j0 + 8] = qb; impB[j0 + 1] = la; if (j0 + 9 < 64) impB[j0 + 9] = lb; } }
            nsa_pv(o, p0, p1, vb_, r32, hi);
        NSA_LOOP_END(ntc)
#pragma unroll
        for (int gq = 0; gq < 16; ++gq) { OT[crow(gq, hi)] = g0 * o[0][gq]; OT[32 + crow(gq, hi)] = g0 * o[1][gq]; }
    } else {
#pragma unroll
        for (int gq = 0; gq < 16; ++gq) { OT[crow(gq, hi)] = 0.f; OT[32 + crow(gq, hi)] = 0.f; }
    }
    const int cur = qt;
    {
        for (int tt = 0; tt < 8; ++tt) { const int tk = 8 * wave + tt;
            const LAS float* iA = (const LAS float*)(lds + NL_IMPA) + tk * 64; const LAS float* iB = (const LAS float*)(lds + NL_IMPB) + tk * 64;
            float v = -INFINITY;
            if (lane <= cur) v = (lane == 0 || lane == cur || lane == cur - 1) ? 1e30f : iA[lane] + iB[lane];
            int rank = 0;
            for (int i = 0; i < 64; ++i) { const float vi = __uint_as_float(__builtin_amdgcn_readlane(__float_as_uint(v), i)); rank += (vi > v || (vi == v && i < lane)) ? 1 : 0; }
            const unsigned long long mk = __ballot(rank < 16 && v > -INFINITY);
            if (lane == 0) *(LAS unsigned long long*)(lds + NL_SEL + tk * 8) = mk; }
    }
    const unsigned long long selm = *(const LAS unsigned long long*)(lds + NL_SEL + (8 * wave + tl) * 8);
    { const float* cosT = (const float*)(ws + WS_ROPE) + t * 32; const float* sinT = cosT + 4096 * 32;
#pragma unroll
      for (int s = 0; s < 2; ++s) {
          const f32x4 ca = *(const f32x4*)(cosT + 16 * s + 8 * hi), cb = *(const f32x4*)(cosT + 16 * s + 8 * hi + 4), sa = *(const f32x4*)(sinT + 16 * s + 8 * hi), sb = *(const f32x4*)(sinT + 16 * s + 8 * hi + 4);
          float x1[8], x2[8]; unpack8(__builtin_bit_cast(u32x4, qf[s]), x1); unpack8(__builtin_bit_cast(u32x4, qf[s + 2]), x2);
          u32x4 a, bq;
          a.x = cvtpk(x1[0] * ca[0] - x2[0] * sa[0], x1[1] * ca[1] - x2[1] * sa[1]); a.y = cvtpk(x1[2] * ca[2] - x2[2] * sa[2], x1[3] * ca[3] - x2[3] * sa[3]);
          a.z = cvtpk(x1[4] * cb[0] - x2[4] * sb[0], x1[5] * cb[1] - x2[5] * sb[1]); a.w = cvtpk(x1[6] * cb[2] - x2[6] * sb[2], x1[7] * cb[3] - x2[7] * sb[3]);
          bq.x = cvtpk(x2[0] * ca[0] + x1[0] * sa[0], x2[1] * ca[1] + x1[1] * sa[1]); bq.y = cvtpk(x2[2] * ca[2] + x1[2] * sa[2], x2[3] * ca[3] + x1[3] * sa[3]);
          bq.z = cvtpk(x2[4] * cb[0] + x1[4] * sb[0], x2[5] * cb[1] + x1[5] * sb[1]); bq.w = cvtpk(x2[6] * cb[2] + x1[6] * sb[2], x2[7] * cb[3] + x1[7] * sb[3]);
          qf[s] = __builtin_bit_cast(bf16x8, a); qf[s + 2] = __builtin_bit_cast(bf16x8, bq); } }
    { m = -1e30f; l = 0.f; o[0] = (f32x16){}; o[1] = (f32x16){};
      NSA_LOOP_BEGIN(KS, VS, 0, cur + 1)
          const bool sel = (selm >> tile) & 1ull;
          if (__any(sel)) {
              nsa_scores(p0, p1, kb_, qf, r32, hi);
#pragma unroll
              for (int gq = 0; gq < 16; ++gq) { const int k0 = crow(gq, hi); const bool ok0 = sel && (tile < cur || k0 <= tw), ok1 = sel && (tile < cur || k0 + 32 <= tw);
                  p0[gq] = ok0 ? p0[gq] * NSA_C2 : -INFINITY; p1[gq] = ok1 ? p1[gq] * NSA_C2 : -INFINITY; }
              nsa_softmax_step(p0, p1, m, l, o);
              nsa_pv(o, p0, p1, vb_, r32, hi); }
      NSA_LOOP_END(cur + 1)
      const float sc = l > 0.f ? g1 / l : 0.f;
#pragma unroll
      for (int gq = 0; gq < 16; ++gq) { OT[crow(gq, hi)] += sc * o[0][gq]; OT[32 + crow(gq, hi)] += sc * o[1][gq]; } }
    { m = -1e30f; l = 0.f; o[0] = (f32x16){}; o[1] = (f32x16){};
      const int jlo = cur >= 8 ? cur - 8 : 0, ntw = cur - jlo + 1;
      NSA_LOOP_BEGIN(KW, VW, jlo, ntw)
          nsa_scores(p0, p1, kb_, qf, r32, hi);
          const bool first = (tile == cur - 8), lastt = (tile == cur);
#pragma unroll
          for (int gq = 0; gq < 16; ++gq) { const int k0 = crow(gq, hi);
              const bool ok0 = (!first || k0 > tw) && (!lastt || k0 <= tw), ok1 = (!first || k0 + 32 > tw) && (!lastt || k0 + 32 <= tw);
              p0[gq] = ok0 ? p0[gq] * NSA_C2 : -INFINITY; p1[gq] = ok1 ? p1[gq] * NSA_C2 : -INFINITY; }
          nsa_softmax_step(p0, p1, m, l, o);
          nsa_pv(o, p0, p1, vb_, r32, hi);
      NSA_LOOP_END(ntw)
      const float sc = l > 0.f ? g2 / l : 0.f;
#pragma unroll
      for (int gq = 0; gq < 16; ++gq) { OT[crow(gq, hi)] += sc * o[0][gq]; OT[32 + crow(gq, hi)] += sc * o[1][gq]; } }
    { const LAS float* OTw = (const LAS float*)(lds + NL_OT) + wave * 32 * 65;
      asm volatile("s_waitcnt lgkmcnt(0)" ::: "memory");
#pragma unroll
      for (int i = 0; i < 4; ++i) { const int item = lane + 64 * i, q = item >> 3, ch = item & 7; const LAS float* src = OTw + q * 65 + 8 * ch;
          const int rr = b * SEQ + tok0 + 8 * wave + (q & 7), col = (g * 4 + (q >> 3)) * 64 + 8 * ch;
          float z[8]; unpack8(*(const u32x4*)((const bf16_t*)(ws + WS_ZA) + (size_t)rr * 512 + col), z);
          u32x4 w; w.x = cvtpk(src[0] * z[0], src[1] * z[1]); w.y = cvtpk(src[2] * z[2], src[3] * z[3]); w.z = cvtpk(src[4] * z[4], src[5] * z[5]); w.w = cvtpk(src[6] * z[6], src[7] * z[7]);
          *(u32x4*)((bf16_t*)(ws + WS_OA) + (size_t)rr * 512 + col) = w; }
      asm volatile("s_waitcnt lgkmcnt(0)" ::: "memory"); }
    BLOCK_SYNC();
}


struct EpiF32 {
    static constexpr bool PERM = true, AFTER_DRAIN = false;
    float* out; int ld;
    __device__ __forceinline__ void operator()(const f32x4 (&acc)[2][2][4][2], const Unit& u, int wr, int wc, int fr, int fq) const {
        const int row0 = u.pm * 256 + wr * 64 + fr, col0 = u.pn * 256 + wc * 32 + 8 * fq;
#pragma unroll
        for (int ai = 0; ai < 2; ++ai)
#pragma unroll
            for (int m = 0; m < 4; ++m)
#pragma unroll
                for (int bj = 0; bj < 2; ++bj) { const size_t off = (size_t)(row0 + ai * 128 + m * 16) * ld + col0 + bj * 128; *(f32x4*)(out + off) = acc[ai][bj][m][0]; *(f32x4*)(out + off + 4) = acc[ai][bj][m][1]; }
    }
};
__device__ __forceinline__ void compress2(unsigned char* ws, const float* w2k, const float* w2v, LAS unsigned char* lds, int gw, int ngw, int lane, int wave) {
    LAS float* hb = (LAS float*)(lds + wave * 512);
    for (int row = gw; row < 8192; row += ngw) { const int kv = row >> 12, bg = (row >> 8) & 15, n = row & 255;
        bf16_t* dst = (bf16_t*)(ws + WS_KCC + (size_t)kv * (MiB / 2)) + ((size_t)bg * 256 + n) * 64 + lane;
        if (n == 255) { *dst = (bf16_t)0; continue; }
        const float* pp = (const float*)(ws + WS_PP + (size_t)kv * 4 * MiB) + (size_t)(bg * 256 + n) * 256; const float* c1 = (const float*)(ws + WS_MISC + MISC_C1) + kv * 128; const float* w2 = kv ? w2v : w2k;
        hb[lane] = siluf_(pp[lane] + pp[256 + 128 + lane] + c1[lane]); hb[64 + lane] = siluf_(pp[64 + lane] + pp[256 + 128 + 64 + lane] + c1[64 + lane]);
        asm volatile("s_waitcnt lgkmcnt(0)" ::: "memory");
        float o = 0.f;
#pragma unroll 8
        for (int j = 0; j < 128; ++j) o += hb[j] * w2[j * 64 + lane];
        *dst = (bf16_t)f2bf(o);
        asm volatile("s_waitcnt lgkmcnt(0)" ::: "memory"); }
}

#define XB_TMO      128
#define XB_XCNT(j)  (256  + 64 * (j))
#define XB_XSUB(j)  (1280 + 64 * (j))
#define XB_XGEN(j)  (2304 + 64 * (j))
#define XB_TOP      3328
#define XB_TOPGEN   3392
#define XCD_BAR_WORDS 3456
#define XB_SPIN_CAP (1u << 18)

__device__ __forceinline__ unsigned xb_ld(unsigned* p)              { return __hip_atomic_load(p, __ATOMIC_RELAXED, __HIP_MEMORY_SCOPE_AGENT); }
__device__ __forceinline__ unsigned xb_add(unsigned* p, unsigned v) { return __hip_atomic_fetch_add(p, v, __ATOMIC_RELAXED, __HIP_MEMORY_SCOPE_AGENT); }
__device__ __forceinline__ unsigned xb_xcc_id() { return (unsigned)__builtin_amdgcn_s_getreg((3 << 11) | 20) & 0xFu; }
#define XB_SPIN(cond, bar) do { unsigned _sp = 0; while (cond) { __builtin_amdgcn_s_sleep(1); \
    if ((++_sp & 255u) == 0u) { if (xb_ld(&(bar)[XB_TMO])) break; if (_sp > XB_SPIN_CAP) { atomicAdd(&(bar)[XB_TMO], 1u); break; } } } } while (0)

struct XcdBarrier {
    unsigned* bar; unsigned x;
    volatile LAS unsigned* st;
};

__device__ __forceinline__ XcdBarrier xcd_barrier_post(unsigned* bar, volatile LAS unsigned* st) {
    XcdBarrier b; b.bar = bar; b.x = xb_xcc_id(); b.st = st;
    if (threadIdx.x == 0) (void)xb_add(&bar[XB_XCNT(b.x)], 1u);
    return b;
}
__device__ __forceinline__ void xcd_barrier_complete(unsigned* bar, unsigned x, unsigned& nloc, unsigned& nx) {
    const unsigned G = gridDim.x * gridDim.y * gridDim.z;
    unsigned sum, cnt, mine, sp = 0u;
    for (;;) {
        sum = 0u; cnt = 0u; mine = 0u;
#pragma unroll
        for (unsigned j = 0; j < 16; ++j) { const unsigned c = xb_ld(&bar[XB_XCNT(j)]); sum += c; cnt += (c > 0u) ? 1u : 0u; mine = (j == x) ? c : mine; }
        if (sum == G) break;
        __builtin_amdgcn_s_sleep(1);
        if ((++sp & 255u) == 0u) { if (xb_ld(&bar[XB_TMO])) break; if (sp > XB_SPIN_CAP) { atomicAdd(&bar[XB_TMO], 1u); break; } }
    }
    nloc = mine > 0u ? mine : 1u; nx = cnt > 0u ? cnt : 1u;
}

__device__ __forceinline__ void xcd_barrier(const XcdBarrier& b) {
    asm volatile("s_waitcnt vmcnt(0)" ::: "memory");
    __syncthreads();
    if (threadIdx.x == 0) {
        unsigned* bar = b.bar;
        __builtin_amdgcn_s_waitcnt(0);
        unsigned nloc = b.st[0], nx = b.st[1];
        if (nloc == 0u) { xcd_barrier_complete(bar, b.x, nloc, nx); b.st[0] = nloc; b.st[1] = nx; }
        const unsigned old = xb_add(&bar[XB_XSUB(b.x)], 1u);
        const unsigned gen = old / nloc;
        if (old + 1u == (gen + 1u) * nloc) {
            __builtin_amdgcn_fence(__ATOMIC_RELEASE, "agent");
            asm volatile("s_waitcnt vmcnt(0)" ::: "memory");
            const unsigned og = xb_add(&bar[XB_TOP], 1u);
            const unsigned tg = og / nx;
            if (og + 1u == (tg + 1u) * nx) xb_add(&bar[XB_TOPGEN], 1u);
            else XB_SPIN(xb_ld(&bar[XB_TOPGEN]) == tg, bar);
            __builtin_amdgcn_fence(__ATOMIC_ACQUIRE, "agent");
            xb_add(&bar[XB_XGEN(b.x)], 1u);
            asm volatile("s_waitcnt vmcnt(0)" ::: "memory");
        } else {
            XB_SPIN(xb_ld(&bar[XB_XGEN(b.x)]) == gen, bar);
            __builtin_amdgcn_fence(__ATOMIC_ACQUIRE, "agent");
            asm volatile("s_waitcnt vmcnt(0)" ::: "memory");
        }
    }
    __syncthreads();
}


struct Args { const float* in[16]; float* out; unsigned char* ws; int ph_lo, ph_hi, sub, pad; };
enum { I_X = 0, I_WIN, I_BIN, I_PEK, I_WK1, I_WK2, I_PEV, I_WV1, I_WV2, I_LB, I_HG, I_WA, I_WB, I_WO, I_LNG, I_LNB };

__global__ void __launch_bounds__(512, 2) mega(Args a) {
    extern __shared__ __attribute__((aligned(16))) unsigned char lds_raw[];
    LAS unsigned char* lds = (LAS unsigned char*)lds_raw;
    const int tid = threadIdx.x, lane = tid & 63, wave = __builtin_amdgcn_readfirstlane(tid >> 6);
    const int G = gridDim.x, bx = blockIdx.x;
    const int gw = bx * 8 + wave, NGW = G * 8;
    unsigned char* ws = a.ws; unsigned char* ob = (unsigned char*)a.out;
    const int lo = a.ph_lo, hi = a.ph_hi;
    volatile LAS unsigned* bst = (volatile LAS unsigned*)(lds + LDS_BYTES - 64);
    if (tid < 16) bst[tid] = 0u;
    __syncthreads();
    XcdBarrier bar = xcd_barrier_post((unsigned*)(ws + WS_CTL) + 4096 + a.pad * XCD_BAR_WORDS, bst);
#define IN(k) (lo <= (k) && (k) < hi)
#define SEAM(k) do { if (IN(k) && IN((k) + 1)) { xcd_barrier(bar); } } while (0)
    if (IN(0)) {
        LAS float* scr = (LAS float*)(lds + wave * 16384);
        constexpr int NI_IN = 16 * (NINP / 32), NI_A = 8 * 32, NI_O = 16 * 32, NI_C = 16 * 4, NITEMS = NI_IN + 2 * NI_A + NI_O + 4 * NI_C;
        for (int it = gw; it < NITEMS; it += NGW) {
            int r = it;
            if (r < NI_IN) { transpose_item(a.in[I_WIN], 1024, NIN, NINP, (bf16_t*)(ws + WS_WIN), scr, r, lane, CMapIn()); continue; } r -= NI_IN;
            if (r < NI_A) { transpose_item(a.in[I_WA], 512, 1024, 1024, (bf16_t*)(ws + WS_WA), scr, r, lane, CMapId()); continue; } r -= NI_A;
            if (r < NI_A) { transpose_item(a.in[I_WB], 512, 1024, 1024, (bf16_t*)(ws + WS_WB), scr, r, lane, CMapId()); continue; } r -= NI_A;
            if (r < NI_O) { transpose_item(a.in[I_WO], 1024, 1024, 1024, (bf16_t*)(ws + WS_WO), scr, r, lane, CMapId()); continue; } r -= NI_O;
            { const int q = r / NI_C, kv = q >> 1, half = q & 1;
              transpose_item(a.in[kv ? I_WV1 : I_WK1] + (size_t)half * 1024 * 128, 1024, 128, 128, (bf16_t*)(ws + WS_W1T + (size_t)kv * (MiB / 2)) + (size_t)half * 128 * 1024, scr, r % NI_C, lane, CMapId()); }
        }
        for (int oi = gw; oi < 256; oi += NGW) { const int kv = oi >> 7, j = oi & 127; const float* pe = a.in[kv ? I_PEV : I_PEK]; const float* w1 = a.in[kv ? I_WV1 : I_WK1];
            float s = 0.f; for (int i = lane; i < 2048; i += 64) s += pe[i] * w1[(size_t)i * 128 + j];
#pragma unroll
            for (int of = 1; of < 64; of <<= 1) s += __shfl_xor(s, of);
            if (lane == 0) ((float*)(ws + WS_MISC + MISC_C1))[oi] = s; }
        for (int m = gw; m < T; m += NGW) { const f32x4* xr = (const f32x4*)(a.in[I_X] + (size_t)m * DM) + lane; u32x2* o8 = (u32x2*)((bf16_t*)(ws + WS_XB) + (size_t)m * DM) + lane;
#pragma unroll
            for (int j = 0; j < 4; ++j) { const f32x4 v = xr[64 * j]; u32x2 o; o.x = pk2(v.x, v.y); o.y = pk2(v.z, v.w); o8[64 * j] = o; } }
        const int gt = bx * 512 + tid, NGT = G * 512;
        float* cosT = (float*)(ws + WS_ROPE); float* sinT = cosT + 4096 * 32;
        for (int i = gt; i < 4096 * 32; i += NGT) { const int pos = i >> 5, k = i & 31; const double rev = (double)pos * ROPE_INVF[k] * 0.15915494309189535; const float fr = (float)(rev - floor(rev));
            cosT[i] = __builtin_amdgcn_cosf(fr); sinT[i] = __builtin_amdgcn_sinf(fr); }
        for (int i = gt; i < NINP; i += NGT) { const int oc = in_colmap(i); ((float*)(ws + WS_MISC + MISC_BIASP))[i] = oc >= 0 ? a.in[I_BIN][oc] : 0.f; }
        for (int i = gt; i < 512; i += NGT) { const float l0 = a.in[I_LB][i], l1 = a.in[I_LB][512 + i]; ((float*)(ws + WS_MISC + MISC_LB))[i] = 1.0f / (1.0f + expf(l1 - l0)); }
    }
    SEAM(0);
    if (IN(1)) {
        pg8::Gemm g{(const bf16_t*)(ws + WS_XB), (const bf16_t*)(ws + WS_WIN), T, NINP, DM}; pg8::StaticOrder S; S.init(T, NINP, G, bx);
        EpiIn E{ws, ob};
        pg8::gemm_phase<EpiIn, pg8::StaticOrder, true, true>(lds, g, S, E);
    }
    SEAM(1);
    if (IN(2)) {
        if (bx < 32) { const int kv = bx >> 4;
            pg8::Gemm g{(const bf16_t*)(ws + WS_KV + (size_t)kv * KV_STRIDE), (const bf16_t*)(ws + WS_W1T + (size_t)kv * (MiB / 2)), 4096, 256, 1024}; pg8::StaticOrder S; S.init(4096, 256, 16, bx & 15);
            EpiF32 E{(float*)(ws + WS_PP + (size_t)kv * 4 * MiB), 256};
            pg8::gemm_phase<EpiF32, pg8::StaticOrder, false, true>(lds, g, S, E); __syncthreads(); }
        for (int u = bx; u < 2048; u += G) hgrn_h1_unit(u, ws, ob, lds, tid, lane, wave); }
    SEAM(2);
    if (IN(3)) { compress2(ws, a.in[I_WK2], a.in[I_WV2], lds, gw, NGW, lane, wave); hgrn_h2(ws, bx * 512 + tid, G * 512); }
    SEAM(3);
    if (IN(4)) {
        if (a.sub != 2) { if (G == 256) { const int bg = bx >> 4, i0 = bx & 15;
            nsa_unit(bg, 63 - i0, ws, lds, tid, lane, wave); nsa_unit(bg, 32 + i0, ws, lds, tid, lane, wave); nsa_unit(bg, 31 - i0, ws, lds, tid, lane, wave); nsa_unit(bg, i0, ws, lds, tid, lane, wave); }
        else { for (int u = bx; u < 1024; u += G) nsa_unit(u >> 6, u & 63, ws, lds, tid, lane, wave); } }
        if (a.sub != 1) for (int u = bx; u < 2048; u += G) hgrn_h3_unit(u, ws, ob, a.in[I_HG], lds, tid, lane, wave); }
    SEAM(4);
    if (IN(5)) {
        { pg8::Gemm g{(const bf16_t*)(ws + WS_OA), (const bf16_t*)(ws + WS_WA), T, DM, 512}; pg8::StaticOrder S; S.init(T, DM, G, bx);
          EpiYA E{(const bf16_t*)(ws + WS_GMA), a.out};
          pg8::gemm_phase<EpiYA, pg8::StaticOrder, true, true>(lds, g, S, E); }
        __syncthreads();
        { pg8::Gemm g{(const bf16_t*)(ws + WS_OB), (const bf16_t*)(ws + WS_WB), T, DM, 512}; pg8::StaticOrder S; S.init(T, DM, G, bx);
          EpiYB E{(const bf16_t*)(ws + WS_GMB), a.out, (bf16_t*)(ws + WS_Y)};
          pg8::gemm_phase<EpiYB, pg8::StaticOrder, true, true>(lds, g, S, E); }
    }
    SEAM(5);
    if (IN(6)) {
        pg8::Gemm g{(const bf16_t*)(ws + WS_Y), (const bf16_t*)(ws + WS_WO), T, DM, DM}; pg8::StaticOrder S; S.init(T, DM, G, bx);
        EpiOut E{a.in[I_X], a.out, 1.189207115002721f};
        pg8::gemm_phase<EpiOut, pg8::StaticOrder, true, true>(lds, g, S, E);
    }
    SEAM(6);
    if (IN(7)) {
        const f32x4* gp = (const f32x4*)a.in[I_LNG] + lane; const f32x4* bp = (const f32x4*)a.in[I_LNB] + lane;
        for (int m = gw; m < T; m += NGW) { f32x4* xr = (f32x4*)(a.out + (size_t)m * DM) + lane;
            f32x4 v[4]; float s = 0.f;
#pragma unroll
            for (int j = 0; j < 4; ++j) { v[j] = xr[64 * j]; s += (v[j].x + v[j].y) + (v[j].z + v[j].w); }
#pragma unroll
            for (int o = 1; o < 64; o <<= 1) s += __shfl_xor(s, o);
            const float mean = s * (1.f / DM); float s2 = 0.f;
#pragma unroll
            for (int j = 0; j < 4; ++j) { v[j] = v[j] - mean; s2 += (v[j].x * v[j].x + v[j].y * v[j].y) + (v[j].z * v[j].z + v[j].w * v[j].w); }
#pragma unroll
            for (int o = 1; o < 64; o <<= 1) s2 += __shfl_xor(s2, o);
            const float rstd = 1.f / sqrtf(s2 * (1.f / DM) + LN_EPS);
#pragma unroll
            for (int j = 0; j < 4; ++j) xr[64 * j] = v[j] * rstd * gp[64 * j] + bp[64 * j]; }
    }
#undef IN
#undef SEAM
}

extern "C" void kernel_launch(void* const* d_in, const int* in_sizes, int n_in, void* d_out, int out_size, void* d_ws, size_t ws_size, hipStream_t stream) {
    static int grid = 0;
    if (grid == 0) {
        if (n_in != 16 || in_sizes[0] != T * DM || out_size != T * DM || ws_size < WS_END) { fprintf(stderr, "kernel_launch: unexpected shapes (n_in %d, in0 %d, out %d, ws %zu)\n", n_in, n_in > 0 ? in_sizes[0] : -1, out_size, ws_size); grid = -1; return; }
        int dev = 0, cus = 0;
        if (hipGetDevice(&dev) != hipSuccess || hipDeviceGetAttribute(&cus, hipDeviceAttributeMultiprocessorCount, dev) != hipSuccess) { grid = -1; return; }
        if (hipFuncSetAttribute((const void*)mega, hipFuncAttributeMaxDynamicSharedMemorySize, LDS_BYTES) != hipSuccess) { fprintf(stderr, "kernel_launch: hipFuncSetAttribute failed\n"); grid = -1; return; }
        int per_cu = 0; if (hipOccupancyMaxActiveBlocksPerMultiprocessor(&per_cu, (const void*)mega, 512, LDS_BYTES) != hipSuccess || per_cu < 1) { fprintf(stderr, "kernel_launch: occupancy query says %d blocks per CU\n", per_cu); grid = -1; return; }
        grid = cus;
    }
    if (grid < 0) return;
    Args a{};
    for (int i = 0; i < 16; ++i) a.in[i] = (const float*)d_in[i];
    a.out = (float*)d_out; a.ws = (unsigned char*)d_ws;
    if (hipMemsetAsync((char*)d_ws + WS_CTL, 0, 65536, stream) != hipSuccess) { fprintf(stderr, "kernel_launch: memset failed\n"); return; }
    void* args[] = {&a}; hipError_t e;
#if defined(PROBE_EXTRA) && defined(PROBE_BEFORE)
    a.ph_lo = (PROBE_EXTRA) / 10; a.ph_hi = a.ph_lo + 1; a.sub = (PROBE_EXTRA) % 10; a.pad = 1; e = hipLaunchCooperativeKernel((const void*)mega, dim3(grid), dim3(512), args, LDS_BYTES, stream);
#endif
    a.ph_lo = 0; a.ph_hi = 8; a.sub = 0; a.pad = 0;
    e = hipLaunchCooperativeKernel((const void*)mega, dim3(grid), dim3(512), args, LDS_BYTES, stream);
#if defined(PROBE_EXTRA) && !defined(PROBE_BEFORE)
    a.ph_lo = (PROBE_EXTRA) / 10; a.ph_hi = a.ph_lo + 1; a.sub = (PROBE_EXTRA) % 10; a.pad = 1; e = hipLaunchCooperativeKernel((const void*)mega, dim3(grid), dim3(512), args, LDS_BYTES, stream);
#endif
    if (e != hipSuccess) fprintf(stderr, "kernel_launch: cooperative launch failed: %s (grid %d)\n", hipGetErrorString(e), grid);
}
```
